# Optimizing an MI355X kernel written in HIP

```python
import math
import jax, jax.numpy as jnp
from jax import lax
import numpy as np

D_MODEL = 1024
BATCH = 4
SEQ = 4096
DEPTH = 4

CONV_WIDTH = D_MODEL
CONV_K = 3
POOL_WIDTH = D_MODEL
POOL_GROUPS = 4
POOL_WINDOWS = (2, 4, 8, 16)
N_HEADS = 16
N_KV_HEADS = 4
HEAD_DIM = D_MODEL // N_HEADS
WINDOW = 128
BLOCK = 128
N_BUCKETS = 32
MAX_DISTANCE = 128
N_BRANCHES = 3
D_FF = -(-8 * D_MODEL // (3 * 256)) * 256

EPS = 1e-6
NEG_INF = -1e30

Q_WIDTH = N_HEADS * HEAD_DIM
KV_WIDTH = N_KV_HEADS * HEAD_DIM
IN_SIZES = (CONV_WIDTH, CONV_WIDTH, CONV_WIDTH, POOL_WIDTH, Q_WIDTH, KV_WIDTH, KV_WIDTH,
            D_MODEL, D_MODEL, D_MODEL)
IN_TOTAL = sum(IN_SIZES)

kernel_name = "hybrid_conv_pool_swa_encoder"


def rms_norm(x, g):
    xf = x.astype(jnp.float32)
    y = xf * lax.rsqrt(jnp.mean(xf * xf, axis=-1, keepdims=True) + EPS)
    return (y * g.astype(jnp.float32)).astype(x.dtype)


def split_points():
    pts, acc = [], 0
    for s in IN_SIZES[:-1]:
        acc += s
        pts.append(acc)
    return pts


def t5_bucket(rel):
    half = N_BUCKETS // 2
    max_exact = half // 2
    ret = jnp.where(rel > 0, half, 0)
    n = jnp.abs(rel)
    nf = jnp.maximum(n, 1).astype(jnp.float32)
    large = max_exact + (jnp.log(nf / max_exact) / math.log(MAX_DISTANCE / max_exact)
                         * (half - max_exact)).astype(jnp.int32)
    large = jnp.minimum(large, half - 1)
    return ret + jnp.where(n < max_exact, n, large)


def short_conv_mixer(b_gate, c_gate, xin, conv_w, w_out):
    u = c_gate * xin
    y = lax.conv_general_dilated(u, conv_w, window_strides=(1,),
                                 padding=[(CONV_K // 2, CONV_K // 2)],
                                 dimension_numbers=("NWC", "WIO", "NWC"),
                                 feature_group_count=u.shape[-1])
    return (b_gate * y) @ w_out


def multiscale_pool_mixer(u, w_pool, pool_scale):
    B, S, W = u.shape
    cg = W // POOL_GROUPS
    uf = u.astype(jnp.float32).reshape(B, S, POOL_GROUPS, cg)
    cs = jnp.pad(jnp.cumsum(uf, axis=1), ((0, 0), (1, 0), (0, 0), (0, 0)))
    t = jnp.arange(S)
    outs = []
    for gi, w in enumerate(POOL_WINDOWS):
        lo = jnp.maximum(t - w // 2, 0)
        hi = jnp.minimum(t + (w - 1 - w // 2), S - 1)
        csg = cs[:, :, gi]
        s = jnp.take(csg, hi + 1, axis=1) - jnp.take(csg, lo, axis=1)
        cnt = (hi - lo + 1).astype(jnp.float32)[None, :, None]
        outs.append(s / cnt - uf[:, :, gi])
    p = jnp.stack(outs, axis=2).astype(u.dtype)
    y = jnp.einsum("bsgc,gcd->bsgd", p, w_pool).reshape(B, S, W)
    return y * pool_scale


def windowed_gqa(q, k, v, rel_bias, sink):
    B, S, _ = q.shape
    nb = S // BLOCK
    G = N_HEADS // N_KV_HEADS
    qb = q.reshape(B, nb, BLOCK, N_KV_HEADS, G, HEAD_DIM)
    pad = ((0, 0), (BLOCK, BLOCK), (0, 0))
    kp = jnp.pad(k, pad).reshape(B, nb + 2, BLOCK, N_KV_HEADS, HEAD_DIM)
    vp = jnp.pad(v, pad).reshape(B, nb + 2, BLOCK, N_KV_HEADS, HEAD_DIM)
    kb = jnp.concatenate([kp[:, :-2], kp[:, 1:-1], kp[:, 2:]], axis=2)
    vb = jnp.concatenate([vp[:, :-2], vp[:, 1:-1], vp[:, 2:]], axis=2)
    scores = jnp.einsum("bnqhgd,bnkhd->bhgnqk", qb, kb,
                        preferred_element_type=jnp.float32) * (HEAD_DIM ** -0.5)
    qi = jnp.arange(BLOCK)[:, None]
    kj = jnp.arange(3 * BLOCK)[None, :]
    rel = kj - BLOCK - qi
    bias = rel_bias[t5_bucket(rel)].astype(jnp.float32)
    bias = jnp.transpose(bias, (2, 0, 1)).reshape(N_KV_HEADS, G, 1, BLOCK, 3 * BLOCK)
    kabs = jnp.arange(nb)[:, None, None] * BLOCK + kj[None] - BLOCK
    valid = (jnp.abs(rel)[None] <= WINDOW) & (kabs >= 0) & (kabs < S)
    scores = jnp.where(valid, scores + bias, NEG_INF)
    sink_l = sink.astype(jnp.float32).reshape(N_KV_HEADS, G, 1, 1, 1)
    m = jnp.maximum(jnp.max(scores, axis=-1, keepdims=True), sink_l)
    p = jnp.exp(scores - m)
    denom = jnp.sum(p, axis=-1, keepdims=True) + jnp.exp(sink_l - m)
    p = (p / denom).astype(v.dtype)
    out = jnp.einsum("bhgnqk,bnkhd->bnqhgd", p, vb)
    return out.reshape(B, S, N_HEADS * HEAD_DIM)


def hybrid_layer(x, w_in, conv_w, w_a_out, w_pool, pool_scale, w_attn_out, sink, w_o,
                 g_mix, g_ffn, w_gu, w_down, rel_bias):
    h = rms_norm(x, g_mix)
    proj = h @ w_in
    b_a, c_a, x_a, u_p, q, k, v, ga, gp, gt = jnp.split(proj, split_points(), axis=-1)
    y_a = short_conv_mixer(b_a, c_a, x_a, conv_w, w_a_out)
    y_p = multiscale_pool_mixer(u_p, w_pool, pool_scale)
    y_t = windowed_gqa(q, k, v, rel_bias, sink) @ w_attn_out
    merged = jax.nn.sigmoid(ga) * y_a + jax.nn.sigmoid(gp) * y_p + jax.nn.sigmoid(gt) * y_t
    x = x + merged @ w_o
    h2 = rms_norm(x, g_ffn)
    gate, up = jnp.split(h2 @ w_gu, [D_FF], axis=-1)
    return x + (jax.nn.silu(gate) * up) @ w_down


def setup_inputs(seed: int = 0) -> dict:
    key = jax.random.key(seed)
    ks = jax.random.split(key, 16)
    nrm = lambda k, shape, scale: jax.random.normal(k, shape, jnp.float32) * scale
    cg = POOL_WIDTH // POOL_GROUPS
    return {
        "x": nrm(ks[0], (BATCH, SEQ, D_MODEL), 1.0),
        "w_in": nrm(ks[1], (DEPTH, D_MODEL, IN_TOTAL), D_MODEL ** -0.5),
        "conv_w": nrm(ks[2], (DEPTH, CONV_K, 1, CONV_WIDTH), CONV_K ** -0.5),
        "w_a_out": nrm(ks[3], (DEPTH, CONV_WIDTH, D_MODEL), CONV_WIDTH ** -0.5),
        "w_pool": nrm(ks[4], (DEPTH, POOL_GROUPS, cg, cg), cg ** -0.5),
        "pool_scale": 1.0 + nrm(ks[5], (DEPTH, POOL_WIDTH), 0.02),
        "w_attn_out": nrm(ks[6], (DEPTH, Q_WIDTH, D_MODEL), Q_WIDTH ** -0.5),
        "attn_sink": nrm(ks[7], (DEPTH, N_HEADS), 0.5),
        "w_o": nrm(ks[8], (DEPTH, D_MODEL, D_MODEL), D_MODEL ** -0.5),
        "g_mix": 1.0 + nrm(ks[9], (DEPTH, D_MODEL), 0.02),
        "g_ffn": 1.0 + nrm(ks[10], (DEPTH, D_MODEL), 0.02),
        "w_gu": nrm(ks[11], (DEPTH, D_MODEL, 2 * D_FF), D_MODEL ** -0.5),
        "w_down": nrm(ks[12], (DEPTH, D_FF, D_MODEL), D_FF ** -0.5),
        "rel_bias": nrm(ks[13], (N_BUCKETS, N_HEADS), 0.5),
        "g_final": 1.0 + nrm(ks[14], (D_MODEL,), 0.02),
    }


def reference(x, w_in, conv_w, w_a_out, w_pool, pool_scale, w_attn_out, attn_sink, w_o,
              g_mix, g_ffn, w_gu, w_down, rel_bias, g_final):
    for layer in range(DEPTH):
        x = hybrid_layer(x, w_in[layer], conv_w[layer], w_a_out[layer], w_pool[layer],
                         pool_scale[layer], w_attn_out[layer], attn_sink[layer], w_o[layer],
                         g_mix[layer], g_ffn[layer], w_gu[layer], w_down[layer], rel_bias)
    return rms_norm(x, g_final)
```

```cpp
#include <hip/hip_runtime.h>
#include <hip/hip_cooperative_groups.h>
#include <cstdio>
#include <cstdint>
#include <cmath>
namespace cg = cooperative_groups;

#ifndef PROBE_REP_MASK
#define PROBE_REP_MASK 0
#endif
#ifndef PROBE_MIX
#define PROBE_MIX 0
#endif
#ifndef PROBE_ATT
#define PROBE_ATT 0
#endif
#ifndef PROBE_XSYNC
#define PROBE_XSYNC 0
#endif
#ifndef MK_MULTI
#define MK_MULTI 0
#endif

#define LAS __attribute__((address_space(3)))
typedef unsigned short bf16_t;
typedef short bf16x8 __attribute__((ext_vector_type(8)));
typedef short s16x4 __attribute__((ext_vector_type(4)));
typedef float f32x4 __attribute__((ext_vector_type(4)));
typedef float f32x16 __attribute__((ext_vector_type(16)));
typedef unsigned u32x4 __attribute__((ext_vector_type(4)));
typedef unsigned u32x2 __attribute__((ext_vector_type(2)));
typedef float f32x2_t __attribute__((ext_vector_type(2)));
typedef __bf16 bf16x2_t __attribute__((ext_vector_type(2)));

constexpr int DM = 1024, BATCH = 4, SEQ = 4096, DEPTH = 4, M = BATCH * SEQ;
constexpr int NH = 16, NKV = 4, HD = 64, DFF = 2816, INTOT = 8704;
constexpr int LDP = 7680;
constexpr int PC_BA = 0, PC_UA = 1024, PC_UP = 2048, PC_Q = 3072, PC_K = 4096, PC_V = 4352, PC_G = 4608;
constexpr float EPS = 1e-6f;

constexpr size_t MiB = 1u << 20;
constexpr size_t WS_WIN = 0;
constexpr size_t WS_WA = 17 * MiB, WS_WT = 19 * MiB, WS_WO = 21 * MiB;
constexpr size_t WS_WP = 41 * MiB;
constexpr size_t WS_WGU = 24 * MiB;
constexpr size_t WS_WD = 35 * MiB;
constexpr size_t WS_PROJ = 48 * MiB;
constexpr size_t WS_HB = 288 * MiB;
constexpr size_t WS_ZA = 320 * MiB, WS_ZP = 352 * MiB, WS_ZT = 384 * MiB;
constexpr size_t WS_CTL = 416 * MiB, CTL_BYTES = 65536;
constexpr size_t WS_PART = 417 * MiB;
constexpr size_t WS_XB = WS_ZA;
constexpr size_t WS_WBUF1 = 418 * MiB;
constexpr size_t WS_END = 466 * MiB;

constexpr int LDS_BYTES = 147456;

__device__ __forceinline__ unsigned cvtpk(float lo, float hi) { f32x2_t v = {lo, hi}; bf16x2_t b = __builtin_convertvector(v, bf16x2_t); return __builtin_bit_cast(unsigned, b); }
__device__ __forceinline__ float bf_lo(unsigned u) { return __uint_as_float(u << 16); }
__device__ __forceinline__ float bf_hi(unsigned u) { return __uint_as_float(u & 0xffff0000u); }
__device__ __forceinline__ float sigmoidf_(float x) { return __builtin_amdgcn_rcpf(1.0f + __expf(-x)); }
#define LDS_WAIT() asm volatile("s_waitcnt lgkmcnt(0)" ::: "memory")
__device__ __forceinline__ void rstd8(const float* part, int row0, int fq, float (&rs)[2][4]) {
    f32x4 pv[2][4];
#pragma unroll
    for (int ai = 0; ai < 2; ++ai)
#pragma unroll
        for (int m = 0; m < 4; ++m) pv[ai][m] = *(const f32x4*)(part + (size_t)(row0 + ai * 128 + m * 16) * 16 + 4 * fq);
#pragma unroll
    for (int ai = 0; ai < 2; ++ai)
#pragma unroll
        for (int m = 0; m < 4; ++m) { float t = (pv[ai][m].x + pv[ai][m].y) + (pv[ai][m].z + pv[ai][m].w); t += __shfl_xor(t, 16); t += __shfl_xor(t, 32);
            rs[ai][m] = __builtin_amdgcn_rsqf(t * (1.0f / 1024.0f) + 1e-6f); }
}

namespace pg8 {
constexpr int BM = 256, BK = 64, HALF = 128, HTB = HALF * BK * 2, STAGE_BYTES = 8 * HTB, NXCD = 8, WGM = 8;
__host__ __device__ __forceinline__ int lds_byte(int r, int c) { const int st = (r >> 4) * 2 + (c >> 5), rr = r & 15, cc = c & 31, ob = rr * 64 + cc * 2; return st * 1024 + (ob ^ (((ob >> 9) & 1) << 5)); }
__host__ __device__ __forceinline__ void stage_rc(int b, int& R, int& C) { const int st = b / 1024, sb = b % 1024, swz = sb ^ (((sb >> 9) & 1) << 5); R = (st >> 1) * 16 + swz / 64; C = (st & 1) * 32 + (swz % 64) / 2; }
__host__ __device__ __forceinline__ int perm32(int rho) { const int n = rho >> 4, i = rho & 15; return 8 * (i >> 2) + 4 * n + (i & 3); }

struct Unit { int pm, pn, br; };
struct Gemm { const bf16_t* A; const bf16_t* Bt; int M, N, K, lda, ldb, agrp; const bf16_t* A1; const bf16_t* Bt1; int K1, agrp1; const bf16_t* A2; const bf16_t* Bt2; int K2, agrp2; };

struct StaticOrder {
    int nM, nN, nwg, G, c;
    __host__ __device__ void init(int M_, int N_, int G_, int c_) { nM = M_ / BM; nN = N_ / BM; nwg = nM * nN; G = G_; c = c_; }
    __host__ __device__ bool next(int i, Unit& u) const {
        const long L = (long)i * G + c; if (L >= nwg) return false;
        int wgid = (int)L; { const int q = nwg / NXCD, r = nwg % NXCD, xcd = wgid % NXCD, off = wgid / NXCD; wgid = (xcd < r ? xcd * (q + 1) : r * (q + 1) + (xcd - r) * q) + off; }
        const int nig = WGM * nN, gid = wgid / nig, fm = gid * WGM, gsz = (nM - fm) < WGM ? (nM - fm) : WGM;
        u.pm = fm + ((wgid % nig) % gsz); u.pn = (wgid % nig) / gsz; u.br = 0; return true;
    }
};
struct MergeOrder {
    StaticOrder base;
    __host__ __device__ __forceinline__ void init(int M_, int N_, int G_, int c_) { base.init(M_, N_, G_, c_); }
    __host__ __device__ __forceinline__ bool next(int i, Unit& u) const { const int q = i / 3, b = i - 3 * q; if (!base.next(q, u)) return false; u.br = b; return true; }
};


struct EpiProj {
    static constexpr bool PERM = true;
    bf16_t* O; const float* part;
    __device__ __forceinline__ void operator()(const f32x4 (&acc)[2][2][4][2], const Unit& u, int wr, int wc, int fr, int fq) const {
        const int row0 = u.pm * BM + wr * 64 + fr; const int pn = u.pn;
        float rsv[2][4]; rstd8(part, row0, fq, rsv);
        if (pn >= 4 && pn < 12) {
            const int col0 = PC_UA + 128 * (pn - 4) + wc * 32 + 8 * fq;
#pragma unroll
            for (int ai = 0; ai < 2; ++ai)
#pragma unroll
                for (int m = 0; m < 4; ++m) { bf16_t* rowp = O + (size_t)(row0 + ai * HALF + m * 16) * LDP + col0;
                    const float rs2 = rsv[ai][m] * rsv[ai][m];
                    const f32x4 v0 = acc[ai][0][m][0] * acc[ai][1][m][0] * rs2, v1 = acc[ai][0][m][1] * acc[ai][1][m][1] * rs2;
                    u32x4 w; w.x = cvtpk(v0[0], v0[1]); w.y = cvtpk(v0[2], v0[3]); w.z = cvtpk(v1[0], v1[1]); w.w = cvtpk(v1[2], v1[3]);
                    __builtin_nontemporal_store(w, (u32x4*)rowp); asm volatile("" ::: "memory"); }
        } else {
            const int colt = pn < 4 ? 256 * pn : 256 * pn - 1024; const int col0 = colt + wc * 32 + 8 * fq; const bool sig = pn >= 22;
#pragma unroll
            for (int ai = 0; ai < 2; ++ai)
#pragma unroll
                for (int m = 0; m < 4; ++m) { bf16_t* rowp = O + (size_t)(row0 + ai * HALF + m * 16) * LDP + col0;
                    const float rs = rsv[ai][m];
#pragma unroll
                    for (int bj = 0; bj < 2; ++bj) { f32x4 v0 = acc[ai][bj][m][0] * rs, v1 = acc[ai][bj][m][1] * rs;
                        if (sig) {
#pragma unroll
                            for (int e = 0; e < 4; ++e) { v0[e] = sigmoidf_(v0[e]); v1[e] = sigmoidf_(v1[e]); } }
                        u32x4 w; w.x = cvtpk(v0[0], v0[1]); w.y = cvtpk(v0[2], v0[3]); w.z = cvtpk(v1[0], v1[1]); w.w = cvtpk(v1[2], v1[3]);
                        __builtin_nontemporal_store(w, (u32x4*)(rowp + bj * HALF)); }
                    asm volatile("" ::: "memory"); }
        }
    }
};
struct EpiMerge {
    static constexpr bool PERM = true;
    bf16_t* Mg; const bf16_t* G0;
    __device__ __forceinline__ void operator()(const f32x4 (&acc)[2][2][4][2], const Unit& u, int wr, int wc, int fr, int fq) const {
        const int row0 = u.pm * BM + wr * 64 + fr; const int col0 = u.pn * BM + wc * 32 + 8 * fq;
        const bf16_t* G = G0 + u.br * DM; const bool first = (u.br == 0);
#pragma unroll
        for (int ai = 0; ai < 2; ++ai)
#pragma unroll
            for (int m = 0; m < 4; ++m) { const size_t row = (size_t)(row0 + ai * HALF + m * 16);
#pragma unroll
                for (int bj = 0; bj < 2; ++bj) {
                    const u32x4 g = *(const u32x4*)(G + row * LDP + col0 + bj * HALF);
                    f32x4 v0 = acc[ai][bj][m][0], v1 = acc[ai][bj][m][1];
                    v0[0] *= bf_lo(g.x); v0[1] *= bf_hi(g.x); v0[2] *= bf_lo(g.y); v0[3] *= bf_hi(g.y);
                    v1[0] *= bf_lo(g.z); v1[1] *= bf_hi(g.z); v1[2] *= bf_lo(g.w); v1[3] *= bf_hi(g.w);
                    bf16_t* op = Mg + row * DM + col0 + bj * HALF;
                    if (!first) { const u32x4 o = *(const u32x4*)op;
                        v0[0] += bf_lo(o.x); v0[1] += bf_hi(o.x); v0[2] += bf_lo(o.y); v0[3] += bf_hi(o.y);
                        v1[0] += bf_lo(o.z); v1[1] += bf_hi(o.z); v1[2] += bf_lo(o.w); v1[3] += bf_hi(o.w); }
                    u32x4 w; w.x = cvtpk(v0[0], v0[1]); w.y = cvtpk(v0[2], v0[3]); w.z = cvtpk(v1[0], v1[1]); w.w = cvtpk(v1[2], v1[3]);
                    *(u32x4*)op = w; }
                asm volatile("" ::: "memory"); }
    }
};
struct EpiResid {
    static constexpr bool PERM = true;
    const float* base; float* out; bf16_t* xb; float* part;
    __device__ __forceinline__ void operator()(const f32x4 (&acc)[2][2][4][2], const Unit& u, int wr, int wc, int fr, int fq) const {
        const int row0 = u.pm * BM + wr * 64 + fr; const int col0 = u.pn * BM + wc * 32 + 8 * fq;
#pragma unroll
        for (int ai = 0; ai < 2; ++ai)
#pragma unroll
            for (int m = 0; m < 4; ++m) { const int row = row0 + ai * HALF + m * 16; const size_t off = (size_t)row * DM + col0; float ss = 0.f;
#pragma unroll
                for (int bj = 0; bj < 2; ++bj) {
                    const f32x4 x0 = *(const f32x4*)(base + off + bj * HALF) + acc[ai][bj][m][0], x1 = *(const f32x4*)(base + off + bj * HALF + 4) + acc[ai][bj][m][1];
                    *(f32x4*)(out + off + bj * HALF) = x0; *(f32x4*)(out + off + bj * HALF + 4) = x1;
                    ss += ((x0[0] * x0[0] + x0[1] * x0[1]) + (x0[2] * x0[2] + x0[3] * x0[3])) + ((x1[0] * x1[0] + x1[1] * x1[1]) + (x1[2] * x1[2] + x1[3] * x1[3]));
                    u32x4 w; w.x = cvtpk(x0[0], x0[1]); w.y = cvtpk(x0[2], x0[3]); w.z = cvtpk(x1[0], x1[1]); w.w = cvtpk(x1[2], x1[3]);
                    *(u32x4*)(xb + off + bj * HALF) = w; }
                ss += __shfl_xor(ss, 16); ss += __shfl_xor(ss, 32);
                if (fq == 0) part[(size_t)row * 16 + u.pn * 4 + wc] = ss;
                asm volatile("" ::: "memory"); }
    }
};
struct EpiAct {
    static constexpr bool PERM = true;
    bf16_t* O; const float* part;
    __device__ __forceinline__ void operator()(const f32x4 (&acc)[2][2][4][2], const Unit& u, int wr, int wc, int fr, int fq) const {
        const int row0 = u.pm * BM + wr * 64 + fr; const int col0 = 128 * u.pn + wc * 32 + 8 * fq;
        float rsv[2][4]; rstd8(part, row0, fq, rsv);
#pragma unroll
        for (int ai = 0; ai < 2; ++ai)
#pragma unroll
            for (int m = 0; m < 4; ++m) { bf16_t* rowp = O + (size_t)(row0 + ai * HALF + m * 16) * DFF + col0;
                const float rs = rsv[ai][m];
                f32x4 v0, v1;
#pragma unroll
                for (int e = 0; e < 4; ++e) { const float g0 = acc[ai][0][m][0][e] * rs, g1 = acc[ai][0][m][1][e] * rs;
                    v0[e] = g0 * sigmoidf_(g0) * (acc[ai][1][m][0][e] * rs); v1[e] = g1 * sigmoidf_(g1) * (acc[ai][1][m][1][e] * rs); }
                u32x4 w; w.x = cvtpk(v0[0], v0[1]); w.y = cvtpk(v0[2], v0[3]); w.z = cvtpk(v1[0], v1[1]); w.w = cvtpk(v1[2], v1[3]);
                __builtin_nontemporal_store(w, (u32x4*)rowp); asm volatile("" ::: "memory"); }
    }
};

template <class Epi, class Sched, bool ALIGN_EPI = true>
__device__ __forceinline__ void gemm_phase(LAS unsigned char* lds, const Gemm g, const Sched& S, const Epi& E) {
    int tid = threadIdx.x; asm volatile("" : "+v"(tid));
    const int wid = __builtin_amdgcn_readfirstlane(tid >> 6), lane = tid & 63, wr = wid >> 2, wc = wid & 3, fr = lane & 15, fq = lane >> 4;
    int nt = g.K / BK;
    unsigned voffA[2], voffB[2];
#pragma unroll
    for (int i = 0; i < 2; ++i) { int R, C; stage_rc(tid * 16 + i * 8192, R, C); const int Rb = Epi::PERM ? ((R & ~31) + perm32(R & 31)) : R;
        voffA[i] = (unsigned)(R * g.lda + C) * 2u; voffB[i] = (unsigned)(Rb * g.ldb + C) * 2u; }
    const size_t kstep = (size_t)(BK * 2);
    const size_t hstepA = (size_t)HALF * g.lda * 2, hstepB = (size_t)HALF * g.ldb * 2;
    const size_t tstepA = 2 * hstepA, tstepB = 2 * hstepB;
#define PG8_ABASE(u) ((u).br == 0 ? (const char*)g.A + (size_t)(u).pm * tstepA + (g.agrp ? (size_t)(u).pn * 512 : (size_t)0) : (u).br == 1 ? (const char*)g.A1 + (size_t)(u).pm * tstepA + (g.agrp1 ? (size_t)(u).pn * 512 : (size_t)0) : (const char*)g.A2 + (size_t)(u).pm * tstepA + (g.agrp2 ? (size_t)(u).pn * 512 : (size_t)0))
#define PG8_BBASE(u) (((u).br == 0 ? (const char*)g.Bt : (u).br == 1 ? (const char*)g.Bt1 : (const char*)g.Bt2) + (size_t)(u).pn * tstepB)
#define PG8_NT(u) (((u).br == 0 ? g.K : (u).br == 1 ? g.K1 : g.K2) / BK)
    const unsigned ldsw = (unsigned)wid * 1024u;
    const int aoff = lds_byte(wr * 64 + fr, fq * 8), boff = lds_byte(wc * 32 + fr, fq * 8);
#define PG8_SA(b, h) (((b) * 2 + (h)) * HTB)
#define PG8_SB(b, h) ((4 + (b) * 2 + (h)) * HTB)
#define PG8_STAGE(bufoff, gbase, voff) do { _Pragma("unroll") for (int _i = 0; _i < 2; ++_i) \
        __builtin_amdgcn_global_load_lds((const unsigned*)((const char*)(gbase) + (voff)[_i]), (LAS unsigned*)(lds + (bufoff) + ldsw + _i * 8192), 16, 0, 0); } while (0)
#define PG8_LDA(dst, b, h) do { _Pragma("unroll") for (int m = 0; m < 4; ++m) _Pragma("unroll") for (int k = 0; k < 2; ++k) dst[m][k] = *(const LAS bf16x8*)(lds + PG8_SA(b, h) + aoff + m * 2048 + k * 1024); } while (0)
#define PG8_LDB(dst, b, h) do { _Pragma("unroll") for (int n = 0; n < 2; ++n) _Pragma("unroll") for (int k = 0; k < 2; ++k) dst[n][k] = *(const LAS bf16x8*)(lds + PG8_SB(b, h) + boff + n * 2048 + k * 1024); } while (0)
#define PG8_MMA(ai, bj, At, Bt) do { __builtin_amdgcn_s_setprio(1); _Pragma("unroll") for (int m = 0; m < 4; ++m) _Pragma("unroll") for (int n = 0; n < 2; ++n) _Pragma("unroll") for (int k = 0; k < 2; ++k) \
        acc[ai][bj][m][n] = __builtin_amdgcn_mfma_f32_16x16x32_bf16(Bt[n][k], At[m][k], acc[ai][bj][m][n], 0, 0, 0); __builtin_amdgcn_s_setprio(0); } while (0)
#define PG8_WAIT_V(n) asm volatile("s_waitcnt vmcnt(" #n ")" ::: "memory")
#define PG8_WAIT_L(n) asm volatile("s_waitcnt lgkmcnt(" #n ")" ::: "memory")
#define PG8_BAR __builtin_amdgcn_s_barrier()
#define PG8_SCHED __builtin_amdgcn_sched_barrier(0)
    Unit cur, nxt; int ui = 0;
    if (!S.next(0, cur)) return;
    f32x4 acc[2][2][4][2];
#pragma unroll
    for (int a = 0; a < 2; ++a)
#pragma unroll
        for (int b = 0; b < 2; ++b)
#pragma unroll
            for (int m = 0; m < 4; ++m)
#pragma unroll
                for (int n = 0; n < 2; ++n) acc[a][b][m][n] = (f32x4){0.f, 0.f, 0.f, 0.f};
    bf16x8 At[4][2], B0[2][2], B1[2][2];
    const char* cA = PG8_ABASE(cur); const char* cB = PG8_BBASE(cur); nt = PG8_NT(cur);
    PG8_STAGE(PG8_SB(0, 0), cB, voffB); PG8_STAGE(PG8_SB(0, 1), cB + hstepB, voffB); PG8_STAGE(PG8_SA(0, 0), cA, voffA); PG8_STAGE(PG8_SA(0, 1), cA + hstepA, voffA);
    if (wr == 1) PG8_BAR;
    PG8_WAIT_V(2); PG8_BAR;
    PG8_STAGE(PG8_SB(1, 0), cB + kstep, voffB); PG8_STAGE(PG8_SA(1, 0), cA + kstep, voffA); PG8_STAGE(PG8_SB(1, 1), cB + hstepB + kstep, voffB);
    PG8_WAIT_V(6); PG8_BAR;
    for (;;) {
        const bool has_next = S.next(ui + 1, nxt);
        const char* nA = has_next ? PG8_ABASE(nxt) : cA; const char* nB = has_next ? PG8_BBASE(nxt) : cB;
        for (int t = 0; t < nt; t += 2) {
            const bool last = (t == nt - 2);
            const char* a1 = cA + (size_t)(t + 1) * kstep;
            const char* a2 = last ? nA : cA + (size_t)(t + 2) * kstep; const char* b2 = last ? nB : cB + (size_t)(t + 2) * kstep;
            const char* a3 = a2 + kstep; const char* b3 = b2 + kstep;
            PG8_LDB(B0, 0, 0); PG8_LDB(B1, 0, 1); PG8_SCHED; PG8_LDA(At, 0, 0); PG8_STAGE(PG8_SA(1, 1), a1 + hstepA, voffA);
            PG8_WAIT_V(8); PG8_WAIT_L(0); PG8_BAR; PG8_MMA(0, 0, At, B0); PG8_MMA(0, 1, At, B1); PG8_BAR; PG8_SCHED;
            PG8_LDA(At, 0, 1); PG8_STAGE(PG8_SB(0, 0), b2, voffB); PG8_STAGE(PG8_SB(0, 1), b2 + hstepB, voffB); PG8_STAGE(PG8_SA(0, 0), a2, voffA);
            PG8_WAIT_V(8); PG8_WAIT_L(0); PG8_BAR; PG8_MMA(1, 0, At, B0); PG8_MMA(1, 1, At, B1); PG8_BAR; PG8_SCHED;
            PG8_LDB(B0, 1, 0); PG8_LDB(B1, 1, 1); PG8_SCHED; PG8_LDA(At, 1, 0); PG8_STAGE(PG8_SA(0, 1), a2 + hstepA, voffA);
            PG8_WAIT_V(8); PG8_WAIT_L(0); PG8_BAR; PG8_MMA(0, 0, At, B0); PG8_MMA(0, 1, At, B1); PG8_BAR; PG8_SCHED;
            PG8_LDA(At, 1, 1); PG8_STAGE(PG8_SB(1, 0), b3, voffB); PG8_STAGE(PG8_SB(1, 1), b3 + hstepB, voffB); PG8_STAGE(PG8_SA(1, 0), a3, voffA);
            PG8_WAIT_V(8); PG8_WAIT_L(0); PG8_BAR; PG8_MMA(1, 0, At, B0); PG8_MMA(1, 1, At, B1); PG8_BAR; PG8_SCHED;
        }
        if constexpr (ALIGN_EPI) { if (wr == 0) PG8_BAR; }
        E(acc, cur, wr, wc, fr, fq);
        if (!has_next) break;
#pragma unroll
        for (int a = 0; a < 2; ++a)
#pragma unroll
            for (int b = 0; b < 2; ++b)
#pragma unroll
                for (int m = 0; m < 4; ++m)
#pragma unroll
                    for (int n = 0; n < 2; ++n) acc[a][b][m][n] = (f32x4){0.f, 0.f, 0.f, 0.f};
        cur = nxt; cA = nA; cB = nB; ++ui; nt = PG8_NT(cur);
        if constexpr (ALIGN_EPI) { if (wr == 1) PG8_BAR; }
    }
    PG8_WAIT_V(0);
    if constexpr (!ALIGN_EPI) { if (wr == 0) PG8_BAR; }
    PG8_BAR;
#undef PG8_ABASE
#undef PG8_BBASE
#undef PG8_NT
#undef PG8_SA
#undef PG8_SB
#undef PG8_STAGE
#undef PG8_LDA
#undef PG8_LDB
#undef PG8_MMA
#undef PG8_WAIT_V
#undef PG8_WAIT_L
#undef PG8_BAR
#undef PG8_SCHED
}
}

struct Args {
    const float* x; const float* w_in; const float* conv_w; const float* w_a_out; const float* w_pool; const float* pool_scale;
    const float* w_attn_out; const float* attn_sink; const float* w_o; const float* g_mix; const float* g_ffn; const float* w_gu;
    const float* w_down; const float* rel_bias; const float* g_final;
    float* out; unsigned char* ws; int ph_lo, ph_hi;
};

struct CvtItem { const float* src; bf16_t* dst; const float* nscale; const float* kscale; int N, ldt; };
__device__ __forceinline__ int map_win(int n0) {
    if (n0 >= 1024 && n0 < 2048) { const int j = n0 - 1024; return 1024 + (j >> 7) * 256 + (j & 127); }
    if (n0 >= 2048 && n0 < 3072) { const int j = n0 - 2048; return 1024 + (j >> 7) * 256 + 128 + (j & 127); }
    return n0;
}
__device__ __forceinline__ int map_wgu(int n0) {
    if (n0 < DFF) return (n0 >> 7) * 256 + (n0 & 127);
    const int j = n0 - DFF; return (j >> 7) * 256 + 128 + (j & 127);
}
constexpr int IT_WIN = 16 * 272, IT_SQ = 16 * 32, IT_POOL = 4 * 32, IT_WGU = 16 * 176, IT_WD = 44 * 32;
constexpr int IT_TOTAL = IT_WIN + 3 * IT_SQ + IT_POOL + IT_WGU + IT_WD;
constexpr int IT_SPLIT = IT_WIN + IT_SQ + IT_POOL;
__device__ __forceinline__ CvtItem cvt_mk(const float* W, int N, bf16_t* WT, int ldt, int k0, int n0, int drow0, const float* nscale, const float* kscale) {
    CvtItem d; d.src = W + (size_t)k0 * N + n0; d.dst = WT + (size_t)drow0 * ldt + k0; d.nscale = nscale ? nscale + n0 : nullptr; d.kscale = kscale ? kscale + k0 : nullptr; d.N = N; d.ldt = ldt; return d;
}
__device__ __forceinline__ CvtItem cvt_decode(const Args& a, int l, unsigned char* ws, int it) {
    int r = it;
    if (r < IT_WIN) { const int kb = r / 272, nb = r % 272; return cvt_mk(a.w_in + (size_t)l * DM * INTOT, INTOT, (bf16_t*)(ws + WS_WIN), DM, 64 * kb, 32 * nb, map_win(32 * nb), nullptr, a.g_mix + (size_t)l * DM); } r -= IT_WIN;
    if (r < IT_SQ) { const int kb = r / 32, nb = r % 32; return cvt_mk(a.w_a_out + (size_t)l * DM * DM, DM, (bf16_t*)(ws + WS_WA), DM, 64 * kb, 32 * nb, 32 * nb, nullptr, nullptr); } r -= IT_SQ;
    if (r < IT_POOL) { const int gi = r / 32, q = r % 32, kb = q / 8, nb = q % 8;
        return cvt_mk(a.w_pool + (size_t)l * 4 * 65536 + (size_t)gi * 65536, 256, (bf16_t*)(ws + WS_WP) + (size_t)gi * 256 * 1024, 1024, 64 * kb, 32 * nb, 32 * nb, a.pool_scale + (size_t)l * DM + gi * 256, nullptr); } r -= IT_POOL;
    if (r < IT_SQ) { const int kb = r / 32, nb = r % 32; return cvt_mk(a.w_attn_out + (size_t)l * DM * DM, DM, (bf16_t*)(ws + WS_WT), DM, 64 * kb, 32 * nb, 32 * nb, nullptr, nullptr); } r -= IT_SQ;
    if (r < IT_SQ) { const int kb = r / 32, nb = r % 32; return cvt_mk(a.w_o + (size_t)l * DM * DM, DM, (bf16_t*)(ws + WS_WO), DM, 64 * kb, 32 * nb, 32 * nb, nullptr, nullptr); } r -= IT_SQ;
    if (r < IT_WGU) { const int kb = r / 176, nb = r % 176; return cvt_mk(a.w_gu + (size_t)l * DM * 2 * DFF, 2 * DFF, (bf16_t*)(ws + WS_WGU), DM, 64 * kb, 32 * nb, map_wgu(32 * nb), nullptr, a.g_ffn + (size_t)l * DM); } r -= IT_WGU;
    { const int kb = r / 32, nb = r % 32; return cvt_mk(a.w_down + (size_t)l * DFF * DM, DM, (bf16_t*)(ws + WS_WD), DFF, 64 * kb, 32 * nb, 32 * nb, nullptr, nullptr); }
}
__device__ __forceinline__ void cvt_load(const CvtItem& d, int lane, f32x4 (&v)[8]) {
    const float* p = d.src + (size_t)(lane >> 3) * d.N + 4 * (lane & 7);
#pragma unroll
    for (int i = 0; i < 8; ++i) v[i] = __builtin_nontemporal_load((const f32x4*)(p + (size_t)(8 * i) * d.N));
}
__device__ __forceinline__ void cvt_lds_write(LAS float* scr, int lane, const f32x4 (&v)[8]) {
    LAS float* q = scr + (lane >> 3) * 33 + 4 * (lane & 7);
#pragma unroll
    for (int i = 0; i < 8; ++i) { q[(8 * i) * 33 + 0] = v[i].x; q[(8 * i) * 33 + 1] = v[i].y; q[(8 * i) * 33 + 2] = v[i].z; q[(8 * i) * 33 + 3] = v[i].w; }
}
__device__ __forceinline__ void cvt_store(const CvtItem& d, const LAS float* scr, int lane) {
    const int c = lane & 7;
    f32x4 ka = (f32x4){1.f, 1.f, 1.f, 1.f}, kb = ka;
    if (d.kscale) { ka = *(const f32x4*)(d.kscale + 8 * c); kb = *(const f32x4*)(d.kscale + 8 * c + 4); }
#pragma unroll
    for (int j = 0; j < 4; ++j) { const int n = (lane >> 3) + 8 * j; const LAS float* s = scr + (8 * c) * 33 + n;
        const float sc = d.nscale ? d.nscale[n] : 1.0f;
        u32x4 o; o.x = cvtpk(s[0 * 33] * (sc * ka[0]), s[1 * 33] * (sc * ka[1])); o.y = cvtpk(s[2 * 33] * (sc * ka[2]), s[3 * 33] * (sc * ka[3])); o.z = cvtpk(s[4 * 33] * (sc * kb[0]), s[5 * 33] * (sc * kb[1])); o.w = cvtpk(s[6 * 33] * (sc * kb[2]), s[7 * 33] * (sc * kb[3]));
        *(u32x4*)(d.dst + (size_t)n * d.ldt + 8 * c) = o; }
}
__device__ __forceinline__ void convert_weights(const Args& a, int l, LAS float* scr, int gw, int ngw, int lane, int it_lo, int it_hi) {
    unsigned char* ws = a.ws + ((l & 1) ? WS_WBUF1 : (size_t)0);
    int it = it_lo + gw; if (it >= it_hi) return;
    CvtItem cur = cvt_decode(a, l, ws, it); f32x4 v[8]; cvt_load(cur, lane, v);
    for (;;) {
        cvt_lds_write(scr, lane, v);
        const int nit = it + ngw; const bool has = nit < it_hi; CvtItem nx = cur;
        if (has) { nx = cvt_decode(a, l, ws, nit); cvt_load(nx, lane, v); }
        LDS_WAIT(); asm volatile("" ::: "memory");
        cvt_store(cur, scr, lane);
        LDS_WAIT(); asm volatile("" ::: "memory");
        if (!has) break;
        cur = nx; it = nit;
    }
}
__device__ __forceinline__ void convert_in_tail(const Args& a, int lnext, LAS unsigned char* lds, int nwg, int G, int bx, int it_lo, int it_hi) {
    int tid = threadIdx.x; asm volatile("" : "+v"(tid));
    const int lane = tid & 63, wave = __builtin_amdgcn_readfirstlane(tid >> 6);
    const int tail = nwg % G;
    if (tail == 0) convert_weights(a, lnext, (LAS float*)(lds + wave * 16384), bx * 8 + wave, G * 8, lane, it_lo, it_hi);
    else if (bx >= tail) convert_weights(a, lnext, (LAS float*)(lds + wave * 16384), (bx - tail) * 8 + wave, (G - tail) * 8, lane, it_lo, it_hi);
}

__device__ __forceinline__ float wave_sum(float v) {
#pragma unroll
    for (int o = 1; o < 64; o <<= 1) v += __shfl_xor(v, o);
    return v;
}
__device__ __forceinline__ void rms_row_bf16(const float* xrow, const float* g, bf16_t* orow, int lane) {
    const f32x4* xr = (const f32x4*)xrow + lane; const f32x4* gr = (const f32x4*)g + lane;
    f32x4 v[4]; float s = 0.f;
#pragma unroll
    for (int j = 0; j < 4; ++j) { v[j] = xr[64 * j]; s += (v[j].x * v[j].x + v[j].y * v[j].y) + (v[j].z * v[j].z + v[j].w * v[j].w); }
    const float rstd = 1.0f / sqrtf(wave_sum(s) * (1.0f / DM) + EPS);
    u32x2* o8 = (u32x2*)orow + lane;
#pragma unroll
    for (int j = 0; j < 4; ++j) { const f32x4 gg = gr[64 * j]; u32x2 w; w.x = cvtpk(v[j].x * rstd * gg.x, v[j].y * rstd * gg.y); w.y = cvtpk(v[j].z * rstd * gg.z, v[j].w * rstd * gg.w); o8[64 * j] = w; }
}
__device__ __forceinline__ void prep_row(const float* xrow, bf16_t* orow, float* prow, int lane) {
    const f32x4* xr = (const f32x4*)xrow + lane;
    f32x4 v[4]; float s = 0.f;
#pragma unroll
    for (int j = 0; j < 4; ++j) { v[j] = xr[64 * j]; s += (v[j].x * v[j].x + v[j].y * v[j].y) + (v[j].z * v[j].z + v[j].w * v[j].w); }
    s = wave_sum(s);
    u32x2* o8 = (u32x2*)orow + lane;
#pragma unroll
    for (int j = 0; j < 4; ++j) { u32x2 w; w.x = cvtpk(v[j].x, v[j].y); w.y = cvtpk(v[j].z, v[j].w); o8[64 * j] = w; }
    if (lane < 16) prow[lane] = lane == 0 ? s : 0.f;
}
__device__ __forceinline__ void rms_row_f32(const float* xrow, const float* g, float* orow, int lane) {
    const f32x4* xr = (const f32x4*)xrow + lane; const f32x4* gr = (const f32x4*)g + lane;
    f32x4 v[4]; float s = 0.f;
#pragma unroll
    for (int j = 0; j < 4; ++j) { v[j] = xr[64 * j]; s += (v[j].x * v[j].x + v[j].y * v[j].y) + (v[j].z * v[j].z + v[j].w * v[j].w); }
    const float rstd = 1.0f / sqrtf(wave_sum(s) * (1.0f / DM) + EPS);
    f32x4* o = (f32x4*)orow + lane;
#pragma unroll
    for (int j = 0; j < 4; ++j) { const f32x4 gg = gr[64 * j]; o[64 * j] = v[j] * rstd * gg; }
}

__device__ __forceinline__ void unpack8(const u32x4 v, float (&f)[8]) {
    f[0] = bf_lo(v.x); f[1] = bf_hi(v.x); f[2] = bf_lo(v.y); f[3] = bf_hi(v.y); f[4] = bf_lo(v.z); f[5] = bf_hi(v.z); f[6] = bf_lo(v.w); f[7] = bf_hi(v.w);
}
__device__ __forceinline__ void store8(bf16_t* p, const float (&f)[8]) {
    u32x4 w; w.x = cvtpk(f[0], f[1]); w.y = cvtpk(f[2], f[3]); w.z = cvtpk(f[4], f[5]); w.w = cvtpk(f[6], f[7]); *(u32x4*)p = w;
}
__device__ __forceinline__ void conv_item(const bf16_t* P, bf16_t* ZA, const float* cw, int m0, int ch) {
    const int t0 = m0 & (SEQ - 1);
    u32x4 U[10], B[8];
#pragma unroll
    for (int j = 0; j < 10; ++j) { const int t = t0 - 1 + j; U[j] = (u32x4){0u, 0u, 0u, 0u}; if ((unsigned)t < (unsigned)SEQ) U[j] = *(const u32x4*)(P + (size_t)(m0 - 1 + j) * LDP + PC_UA + ch); }
#pragma unroll
    for (int i = 0; i < 8; ++i) B[i] = *(const u32x4*)(P + (size_t)(m0 + i) * LDP + PC_BA + ch);
    float w0[8], w1[8], w2[8];
#pragma unroll
    for (int e = 0; e < 8; ++e) { w0[e] = cw[ch + e]; w1[e] = cw[DM + ch + e]; w2[e] = cw[2 * DM + ch + e]; }
    float up[8], uc[8], un[8], bb[8], o[8];
    unpack8(U[0], up); unpack8(U[1], uc);
#pragma unroll
    for (int i = 0; i < 8; ++i) { unpack8(U[i + 2], un); unpack8(B[i], bb);
#pragma unroll
        for (int e = 0; e < 8; ++e) { o[e] = bb[e] * (w0[e] * up[e] + w1[e] * uc[e] + w2[e] * un[e]); up[e] = uc[e]; uc[e] = un[e]; }
        store8(ZA + (size_t)(m0 + i) * DM + ch, o); }
}
template <int W> __device__ __forceinline__ void pool_item(const bf16_t* P, bf16_t* ZP, int m0, int ch) {
    constexpr int NL = W + 7, H = W / 2;
    const int t0 = m0 & (SEQ - 1);
    u32x4 L[NL];
#pragma unroll
    for (int j = 0; j < NL; ++j) { const int t = t0 - H + j; L[j] = (u32x4){0u, 0u, 0u, 0u}; if ((unsigned)t < (unsigned)SEQ) L[j] = *(const u32x4*)(P + (size_t)(m0 - H + j) * LDP + PC_UP + ch); }
    float sum[8], tmp[8], o[8];
#pragma unroll
    for (int e = 0; e < 8; ++e) sum[e] = 0.f;
#pragma unroll
    for (int j = 0; j < W; ++j) { unpack8(L[j], tmp);
#pragma unroll
        for (int e = 0; e < 8; ++e) sum[e] += tmp[e]; }
#pragma unroll
    for (int i = 0; i < 8; ++i) {
        if (i > 0) { unpack8(L[W - 1 + i], tmp);
#pragma unroll
            for (int e = 0; e < 8; ++e) sum[e] += tmp[e];
            unpack8(L[i - 1], tmp);
#pragma unroll
            for (int e = 0; e < 8; ++e) sum[e] -= tmp[e]; }
        const int t = t0 + i, lo = (t - H) > 0 ? (t - H) : 0, hi = (t + H - 1) < SEQ - 1 ? (t + H - 1) : SEQ - 1;
        const float inv = 1.0f / (float)(hi - lo + 1);
        unpack8(L[H + i], tmp);
#pragma unroll
        for (int e = 0; e < 8; ++e) o[e] = sum[e] * inv - tmp[e];
        store8(ZP + (size_t)(m0 + i) * DM + ch, o); }
}
__device__ __forceinline__ void convpool_phase(const Args& a, int l, int gwv, int ngw, int lane) {
    const bf16_t* P = (const bf16_t*)(a.ws + WS_PROJ);
    bf16_t* ZA = (bf16_t*)(a.ws + WS_ZA); bf16_t* ZP = (bf16_t*)(a.ws + WS_ZP);
    const float* cw = a.conv_w + (size_t)l * 3 * DM;
    for (int ci = gwv; ci < (M / 8) * 2; ci += ngw) conv_item(P, ZA, cw, (ci >> 1) * 8, ((ci & 1) * 64 + lane) * 8);
    for (int wi = gwv; wi < (M / 16) * 4; wi += ngw) { const int gi = wi & 3, m0 = ((wi >> 2) * 2 + (lane >> 5)) * 8, ch = (32 * gi + (lane & 31)) * 8;
        if (gi == 0) pool_item<2>(P, ZP, m0, ch); else if (gi == 1) pool_item<4>(P, ZP, m0, ch); else if (gi == 2) pool_item<8>(P, ZP, m0, ch); else pool_item<16>(P, ZP, m0, ch); }
}

constexpr int AT_KP = 144;
constexpr int AT_K = 0, AT_V = 384 * AT_KP, AT_B = AT_V + 384 * AT_KP, AT_BP = 320;
static_assert(AT_B + 16 * AT_BP * 4 <= 131072, "attention LDS");
constexpr float LOG2E = 1.4426950408889634f;
__device__ __forceinline__ int crow(int reg, int h) { return (reg & 3) + 8 * (reg >> 2) + 4 * h; }
__device__ __forceinline__ int t5_bucket(int rel) {
    const int n = rel < 0 ? -rel : rel;
    const int b = n < 8 ? n : n < 12 ? 8 : n < 16 ? 9 : n < 23 ? 10 : n < 32 ? 11 : n < 46 ? 12 : n < 64 ? 13 : n < 91 ? 14 : 15;
    return (rel > 0 ? 16 : 0) + b;
}
#define MFMA32(a, b, c) __builtin_amdgcn_mfma_f32_32x32x16_bf16((a), (b), (c), 0, 0, 0)

typedef short v4i16_t __attribute__((ext_vector_type(4)));
__device__ __forceinline__ s16x4 vtr(const LAS unsigned char* p) { return __builtin_bit_cast(s16x4, __builtin_amdgcn_ds_read_tr16_b64_v4i16((LAS v4i16_t*)p)); }
__device__ __forceinline__ void attn_qtile(const LAS unsigned char* lds, const LAS float* bt, const bf16x8 (&qf)[4], int lane, int r, int hh, int qrel, int t0, int tlo, int thi, float sink8, bf16_t* orow) {
    const float C2 = 0.125f * LOG2E;
    float mrun = sink8, lrun = 0.f;
    f32x16 o0, o1;
#pragma unroll
    for (int i = 0; i < 16; ++i) { o0[i] = 0.f; o1[i] = 0.f; }
#pragma unroll 1
    for (int c = 0; c < 3; ++c) {
        f32x16 s[3];
#pragma unroll
        for (int tt = 0; tt < 3; ++tt) { const int kvt = t0 + 3 * c + tt;
            const LAS float* bp = bt + (32 * kvt - qrel + 4 * hh + 32);
#pragma unroll
            for (int i = 0; i < 16; ++i) s[tt][i] = bp[(i & 3) + 8 * (i >> 2)];
            const LAS unsigned char* kp = lds + AT_K + (kvt * 32 + r) * AT_KP + hh * 16;
#pragma unroll
            for (int ds = 0; ds < 4; ++ds) { const bf16x8 kf = *(const LAS bf16x8*)(kp + ds * 32); s[tt] = MFMA32(kf, qf[ds], s[tt]); } }
        float cm = -INFINITY;
#pragma unroll
        for (int tt = 0; tt < 3; ++tt) { const int kvt = t0 + 3 * c + tt; const bool tinv = (kvt < tlo) || (kvt >= thi);
#pragma unroll
            for (int i = 0; i < 16; ++i) { if (tinv) s[tt][i] = -INFINITY; cm = fmaxf(cm, s[tt][i]); } }
        { auto rr = __builtin_amdgcn_permlane32_swap(__float_as_uint(cm), __float_as_uint(cm), false, false); cm = fmaxf(__uint_as_float(rr[0]), __uint_as_float(rr[1])); }
        const float mnew = fmaxf(mrun, cm), alpha = __builtin_amdgcn_exp2f((mrun - mnew) * C2), nm = -mnew * C2;
        float ps0 = 0.f, ps1 = 0.f;
#pragma unroll
        for (int tt = 0; tt < 3; ++tt)
#pragma unroll
            for (int i = 0; i < 16; i += 2) { const float p0 = __builtin_amdgcn_exp2f(__builtin_fmaf(s[tt][i], C2, nm)), p1 = __builtin_amdgcn_exp2f(__builtin_fmaf(s[tt][i + 1], C2, nm)); s[tt][i] = p0; s[tt][i + 1] = p1; ps0 += p0; ps1 += p1; }
        lrun = lrun * alpha + (ps0 + ps1); mrun = mnew;
#pragma unroll
        for (int i = 0; i < 16; ++i) { o0[i] *= alpha; o1[i] *= alpha; }
#pragma unroll
        for (int tt = 0; tt < 3; ++tt) { const int kvt = t0 + 3 * c + tt;
#pragma unroll
            for (int st = 0; st < 2; ++st) {
                u32x4 pw; pw.x = cvtpk(s[tt][8 * st + 0], s[tt][8 * st + 1]); pw.y = cvtpk(s[tt][8 * st + 2], s[tt][8 * st + 3]);
                pw.z = cvtpk(s[tt][8 * st + 4], s[tt][8 * st + 5]); pw.w = cvtpk(s[tt][8 * st + 6], s[tt][8 * st + 7]);
                const bf16x8 pk = __builtin_bit_cast(bf16x8, pw);
                const LAS unsigned char* vp = lds + AT_V + (32 * kvt + 16 * st + 4 * hh + ((lane & 15) >> 2)) * AT_KP + 32 * ((lane >> 4) & 1) + 8 * (lane & 3);
                { const s16x4 lo = vtr(vp), hi = vtr(vp + 8 * AT_KP);
                  const bf16x8 vf = __builtin_shufflevector(lo, hi, 0, 1, 2, 3, 4, 5, 6, 7); o0 = MFMA32(vf, pk, o0); }
                { const s16x4 lo = vtr(vp + 64), hi = vtr(vp + 64 + 8 * AT_KP);
                  const bf16x8 vf = __builtin_shufflevector(lo, hi, 0, 1, 2, 3, 4, 5, 6, 7); o1 = MFMA32(vf, pk, o1); }
            } }
    }
    lrun += __shfl_xor(lrun, 32);
    lrun += __builtin_amdgcn_exp2f((sink8 - mrun) * C2);
    const float inv = 1.0f / lrun;
#pragma unroll
    for (int g4 = 0; g4 < 4; ++g4) {
        u32x2 w0, w1;
        w0.x = cvtpk(o0[4 * g4 + 0] * inv, o0[4 * g4 + 1] * inv); w0.y = cvtpk(o0[4 * g4 + 2] * inv, o0[4 * g4 + 3] * inv);
        w1.x = cvtpk(o1[4 * g4 + 0] * inv, o1[4 * g4 + 1] * inv); w1.y = cvtpk(o1[4 * g4 + 2] * inv, o1[4 * g4 + 3] * inv);
        *(u32x2*)(orow + 8 * g4 + 4 * hh) = w0; *(u32x2*)(orow + 32 + 8 * g4 + 4 * hh) = w1; }
}

__device__ __forceinline__ void attn_unit(const Args& a, int l, int unit, LAS unsigned char* lds) {
    int tid = threadIdx.x; asm volatile("" : "+v"(tid));
    const int lane = tid & 63, wid = __builtin_amdgcn_readfirstlane(tid >> 6), r = lane & 31, hh = lane >> 5;
    const int kvh = unit & 3, blk = (unit >> 2) & 31, b = unit >> 7;
    const bf16_t* P = (const bf16_t*)(a.ws + WS_PROJ);
    bf16_t* ZT = (bf16_t*)(a.ws + WS_ZT);
    const size_t rowb = (size_t)b * SEQ;
    const int kbase = blk * 128 - 128;
    for (int srep = 0; srep < ((PROBE_ATT & 1) ? 2 : 1); ++srep) {
    if (srep) __syncthreads();
#pragma unroll
    for (int i = 0; i < 6; ++i) { const int c = tid + 512 * i, kv = c >> 3, dch = c & 7, kabs = kbase + kv;
        u32x4 v = (u32x4){0u, 0u, 0u, 0u};
        if ((unsigned)kabs < (unsigned)SEQ) v = *(const u32x4*)(P + (rowb + kabs) * LDP + PC_K + kvh * 64 + dch * 8);
        *(LAS u32x4*)(lds + AT_K + kv * AT_KP + dch * 16) = v; }
#pragma unroll
    for (int i = 0; i < 6; ++i) { const int c = tid + 512 * i, kv = c >> 3, dch = c & 7, kabs = kbase + kv;
        u32x4 v = (u32x4){0u, 0u, 0u, 0u};
        if ((unsigned)kabs < (unsigned)SEQ) v = *(const u32x4*)(P + (rowb + kabs) * LDP + PC_V + kvh * 64 + dch * 8);
        *(LAS u32x4*)(lds + AT_V + kv * AT_KP + dch * 16) = v; }
    }
    __syncthreads();
    const int g = wid >> 1, head = kvh * 4 + g;
    const float sink8 = a.attn_sink[l * NH + head] * 8.0f;
    const int tlo = blk == 0 ? 4 : 0, thi = blk == 31 ? 8 : 12;
    const LAS float* bt = (const LAS float*)(lds + AT_B) + head * AT_BP;
#pragma unroll 1
    for (int qtt = 0; qtt < ((PROBE_ATT & 2) ? 4 : 2); ++qtt) { const int qt = qtt & 1;
        const int qo = 64 * (wid & 1) + 32 * qt, qrel = qo + r, t0 = qo >> 5;
        const size_t qrow = rowb + blk * 128 + qrel;
        bf16x8 qf[4];
#pragma unroll
        for (int ds = 0; ds < 4; ++ds) qf[ds] = *(const bf16x8*)(P + qrow * LDP + PC_Q + head * 64 + ds * 16 + 8 * hh);
        bf16_t* orow = ZT + qrow * DM + head * 64;
        attn_qtile(lds, bt, qf, lane, r, hh, qrel, t0, tlo, thi, sink8, orow);
    }
    __syncthreads();
}

#define XB_TMO      128
#define XB_XCNT(j)  (256  + 64 * (j))
#define XB_XSUB(j)  (1280 + 64 * (j))
#define XB_XGEN(j)  (2304 + 64 * (j))
#define XB_TOP      3328
#define XB_TOPGEN   3392
#define XCD_BAR_WORDS 3456
#define XB_SPIN_CAP (1u << 18)
__device__ __forceinline__ unsigned xb_ld(unsigned* p)              { return __hip_atomic_load(p, __ATOMIC_RELAXED, __HIP_MEMORY_SCOPE_AGENT); }
__device__ __forceinline__ unsigned xb_add(unsigned* p, unsigned v) { return __hip_atomic_fetch_add(p, v, __ATOMIC_RELAXED, __HIP_MEMORY_SCOPE_AGENT); }
__device__ __forceinline__ unsigned xb_xcc_id() { return (unsigned)__builtin_amdgcn_s_getreg((3 << 11) | 20) & 0xFu; }
#define XB_SPIN(cond, bar) do { unsigned _sp = 0; while (cond) { __builtin_amdgcn_s_sleep(1); \
    if ((++_sp & 255u) == 0u) { if (xb_ld(&(bar)[XB_TMO])) break; if (_sp > XB_SPIN_CAP) { atomicAdd(&(bar)[XB_TMO], 1u); break; } } } } while (0)
struct XcdBarrier { unsigned* bar; unsigned x; volatile LAS unsigned* st; };
__device__ __forceinline__ XcdBarrier xcd_barrier_post(unsigned* bar, volatile LAS unsigned* st) {
    XcdBarrier b; b.bar = bar; b.x = xb_xcc_id(); b.st = st;
    if (threadIdx.x == 0) (void)xb_add(&bar[XB_XCNT(b.x)], 1u);
    return b;
}
__device__ __forceinline__ void xcd_barrier_complete(unsigned* bar, unsigned x, unsigned& nloc, unsigned& nx) {
    const unsigned G = gridDim.x * gridDim.y * gridDim.z;
    unsigned sum, cnt, mine, sp = 0u;
    for (;;) {
        sum = 0u; cnt = 0u; mine = 0u;
#pragma unroll
        for (unsigned j = 0; j < 16; ++j) { const unsigned c = xb_ld(&bar[XB_XCNT(j)]); sum += c; cnt += (c > 0u) ? 1u : 0u; mine = (j == x) ? c : mine; }
        if (sum == G) break;
        __builtin_amdgcn_s_sleep(1);
        if ((++sp & 255u) == 0u) { if (xb_ld(&bar[XB_TMO])) break; if (sp > XB_SPIN_CAP) { atomicAdd(&bar[XB_TMO], 1u); break; } }
    }
    nloc = mine > 0u ? mine : 1u; nx = cnt > 0u ? cnt : 1u;
}
__device__ __forceinline__ void xcd_barrier(const XcdBarrier& b) {
    asm volatile("s_waitcnt vmcnt(0)" ::: "memory");
    __syncthreads();
    if (threadIdx.x == 0) {
        unsigned* bar = b.bar;
        __builtin_amdgcn_s_waitcnt(0);
        unsigned nloc = b.st[0], nx = b.st[1];
        if (nloc == 0u) { xcd_barrier_complete(bar, b.x, nloc, nx); b.st[0] = nloc; b.st[1] = nx; }
        const unsigned old = xb_add(&bar[XB_XSUB(b.x)], 1u);
        const unsigned gen = old / nloc;
        if (old + 1u == (gen + 1u) * nloc) {
            __builtin_amdgcn_fence(__ATOMIC_RELEASE, "agent");
            asm volatile("s_waitcnt vmcnt(0)" ::: "memory");
            const unsigned og = xb_add(&bar[XB_TOP], 1u);
            const unsigned tg = og / nx;
            if (og + 1u == (tg + 1u) * nx) xb_add(&bar[XB_TOPGEN], 1u);
            else XB_SPIN(xb_ld(&bar[XB_TOPGEN]) == tg, bar);
            __builtin_amdgcn_fence(__ATOMIC_ACQUIRE, "agent");
            xb_add(&bar[XB_XGEN(b.x)], 1u);
            asm volatile("s_waitcnt vmcnt(0)" ::: "memory");
        } else {
            XB_SPIN(xb_ld(&bar[XB_XGEN(b.x)]) == gen, bar);
            __builtin_amdgcn_fence(__ATOMIC_ACQUIRE, "agent");
            asm volatile("s_waitcnt vmcnt(0)" ::: "memory");
        }
    }
    __syncthreads();
}

__global__ void __launch_bounds__(512, 2) fwd_megakernel(Args a) {
    extern __shared__ __attribute__((aligned(16))) unsigned char lds_raw[];
    LAS unsigned char* lds = (LAS unsigned char*)lds_raw;
    cg::grid_group grid = cg::this_grid();
    const int G = gridDim.x, bx = blockIdx.x;
#define PH_TID() int tid = threadIdx.x; asm volatile("" : "+v"(tid)); const int lane = tid & 63, wave = __builtin_amdgcn_readfirstlane(tid >> 6); (void)lane; (void)wave
    unsigned char* ws = a.ws;
    volatile LAS unsigned* bst = (volatile LAS unsigned*)(lds + 131072);
    if (threadIdx.x < 2) bst[threadIdx.x] = 0u;
    __syncthreads();
    const XcdBarrier bar = xcd_barrier_post((unsigned*)(ws + WS_CTL), bst);
    if (a.ph_lo > a.ph_hi) grid.sync();
#define GRID_BAR() xcd_barrier(bar)
    bf16_t* PROJ = (bf16_t*)(ws + WS_PROJ); bf16_t* ACT = PROJ; bf16_t* HB = (bf16_t*)(ws + WS_HB); bf16_t* XB = (bf16_t*)(ws + WS_XB); float* PART = (float*)(ws + WS_PART);
    float* X = a.out;

    for (int p = a.ph_lo; p < a.ph_hi; ++p) {
        const int l = p >> 3, sub = p & 7;
        const unsigned char* wsw = ws + ((l & 1) ? WS_WBUF1 : (size_t)0);
        if (p < 8 * DEPTH && (sub == 5 || (sub == 0 && l > 0))) continue;
        for (int rep = 0; rep < ((p < 8 * DEPTH && ((PROBE_REP_MASK >> sub) & 1)) ? 2 : 1); ++rep) {
        if (rep) GRID_BAR();
        if (p == 8 * DEPTH) {
            PH_TID();
            for (int m = bx * 8 + wave; m < M; m += G * 8) rms_row_f32(X + (size_t)m * DM, a.g_final, X + (size_t)m * DM, lane);
        } else if (sub == 0) {
            PH_TID();
#ifndef DIS_CVT
            convert_weights(a, l, (LAS float*)(lds + wave * 16384), bx * 8 + wave, G * 8, lane, 0, IT_TOTAL);
#endif
            if (l == 0) for (int m = bx * 8 + wave; m < M; m += G * 8) prep_row(a.x + (size_t)m * DM, XB + (size_t)m * DM, PART + (size_t)m * 16, lane);
        } else if (sub == 1) {
            pg8::Gemm g{XB, (const bf16_t*)(wsw + WS_WIN), M, INTOT, DM, DM, DM, 0}; pg8::StaticOrder S; S.init(M, INTOT, G, bx);
            pg8::EpiProj E{PROJ, PART};
#ifndef DIS_PROJ
            pg8::gemm_phase<pg8::EpiProj, pg8::StaticOrder>(lds, g, S, E);
#endif
            if (l + 1 < DEPTH) convert_in_tail(a, l + 1, lds, S.nwg, G, bx, 0, IT_SPLIT);
        } else if (sub == 2) {
            PH_TID();
            { LAS float* bt = (LAS float*)(lds + AT_B);
              for (int i = tid; i < 16 * AT_BP; i += 512) { const int h = i / AT_BP, idx = i - h * AT_BP - 32;
                  bt[i] = ((unsigned)idx <= 256u) ? a.rel_bias[t5_bucket(idx - 128) * NH + h] * 8.0f : -INFINITY; } }
            __syncthreads();
            if (bx & 1) {
                for (int rr = 0; rr < ((PROBE_MIX & 2) ? 2 : 1); ++rr) convpool_phase(a, l, bx * 8 + wave, G * 8, lane);
            }
#ifndef DIS_ATTN
            for (int rr = 0; rr < ((PROBE_MIX & 1) ? 2 : 1); ++rr)
            for (int u = bx; u < BATCH * 32 * NKV; u += G) attn_unit(a, l, u, lds);
#endif
            if (!(bx & 1)) {
                for (int rr = 0; rr < ((PROBE_MIX & 2) ? 2 : 1); ++rr) convpool_phase(a, l, bx * 8 + wave, G * 8, lane);
            }
        } else if (sub == 3) {
            pg8::Gemm g{(const bf16_t*)(ws + WS_ZA), (const bf16_t*)(wsw + WS_WA), M, DM, DM, DM, DM, 0,
                        (const bf16_t*)(ws + WS_ZP), (const bf16_t*)(wsw + WS_WP), 256, 1,
                        (const bf16_t*)(ws + WS_ZT), (const bf16_t*)(wsw + WS_WT), DM, 0};
            pg8::MergeOrder S; S.init(M, DM, G, bx);
            pg8::EpiMerge E{HB, PROJ + PC_G};
#ifndef DIS_MERGE
            pg8::gemm_phase<pg8::EpiMerge, pg8::MergeOrder>(lds, g, S, E);
#endif
        } else if (sub == 4 || sub == 7) {
            pg8::Gemm g; pg8::StaticOrder S; S.init(M, DM, G, bx);
            if (sub == 4) g = pg8::Gemm{HB, (const bf16_t*)(wsw + WS_WO), M, DM, DM, DM, DM, 0};
            else g = pg8::Gemm{ACT, (const bf16_t*)(wsw + WS_WD), M, DM, DFF, DFF, DFF, 0};
            pg8::EpiResid E{(sub == 4 && l == 0) ? a.x : (const float*)X, X, XB, PART};
#ifndef DIS_RESID
            pg8::gemm_phase<pg8::EpiResid, pg8::StaticOrder>(lds, g, S, E);
#endif
        } else {
            pg8::Gemm g{XB, (const bf16_t*)(wsw + WS_WGU), M, 2 * DFF, DM, DM, DM, 0}; pg8::StaticOrder S; S.init(M, 2 * DFF, G, bx);
            pg8::EpiAct E{ACT, PART};
#ifndef DIS_ACT
            pg8::gemm_phase<pg8::EpiAct, pg8::StaticOrder>(lds, g, S, E);
#endif
            if (l + 1 < DEPTH) convert_in_tail(a, l + 1, lds, S.nwg, G, bx, IT_SPLIT, IT_TOTAL);
        }
        }
        if (p + 1 < a.ph_hi) { GRID_BAR(); for (int xs = 0; xs < PROBE_XSYNC; ++xs) GRID_BAR(); }
    }
}

extern "C" void kernel_launch(void* const* d_in, const int* in_sizes, int n_in, void* d_out, int out_size, void* d_ws, size_t ws_size, hipStream_t stream) {
    static int grid = 0;
    if (grid == 0) {
        if (n_in != 15 || out_size != M * DM || ws_size < WS_END) { fprintf(stderr, "kernel_launch: unexpected problem (n_in %d out %d ws %zu)\n", n_in, out_size, ws_size); grid = -1; return; }
        int dev = 0, cus = 0, per_cu = 0;
        hipGetDevice(&dev); hipDeviceGetAttribute(&cus, hipDeviceAttributeMultiprocessorCount, dev);
        hipFuncSetAttribute((const void*)fwd_megakernel, hipFuncAttributeMaxDynamicSharedMemorySize, LDS_BYTES);
        hipOccupancyMaxActiveBlocksPerMultiprocessor(&per_cu, (const void*)fwd_megakernel, 512, LDS_BYTES);
        (void)hipGetLastError();
        if (per_cu < 1) { fprintf(stderr, "kernel_launch: occupancy query says %d blocks/CU\n", per_cu); per_cu = 1; }
        grid = cus;
    }
    if (grid < 0) return;
    Args a{};
    a.x = (const float*)d_in[0]; a.w_in = (const float*)d_in[1]; a.conv_w = (const float*)d_in[2]; a.w_a_out = (const float*)d_in[3];
    a.w_pool = (const float*)d_in[4]; a.pool_scale = (const float*)d_in[5]; a.w_attn_out = (const float*)d_in[6]; a.attn_sink = (const float*)d_in[7];
    a.w_o = (const float*)d_in[8]; a.g_mix = (const float*)d_in[9]; a.g_ffn = (const float*)d_in[10]; a.w_gu = (const float*)d_in[11];
    a.w_down = (const float*)d_in[12]; a.rel_bias = (const float*)d_in[13]; a.g_final = (const float*)d_in[14];
    a.out = (float*)d_out; a.ws = (unsigned char*)d_ws;
    hipMemsetAsync((unsigned char*)d_ws + WS_CTL, 0, CTL_BYTES, stream);
#if MK_MULTI
    for (int p = 0; p <= 8 * DEPTH; ++p) { a.ph_lo = p; a.ph_hi = p + 1; hipLaunchKernelGGL(fwd_megakernel, dim3(grid), dim3(512), LDS_BYTES, stream, a); }
#else
    a.ph_lo = 0; a.ph_hi = 8 * DEPTH + 1;
    void* args[] = {&a};
    hipError_t e = hipLaunchCooperativeKernel((const void*)fwd_megakernel, dim3(grid), dim3(512), args, LDS_BYTES, stream);
    if (e != hipSuccess) fprintf(stderr, "cooperative launch failed: %s (grid %d)\n", hipGetErrorString(e), grid);
#endif
}
```

```cpp
#include <hip/hip_runtime.h>
#include <hip/hip_cooperative_groups.h>
#include <cstdio>
#include <cstdint>
#include <cmath>
namespace cg = cooperative_groups;

#ifndef PROBE_REP_MASK
#define PROBE_REP_MASK 0
#endif
#ifndef PROBE_MIX
#define PROBE_MIX 0
#endif
#ifndef PROBE_ATT
#define PROBE_ATT 0
#endif
#ifndef PROBE_XSYNC
#define PROBE_XSYNC 0
#endif
#ifndef MK_MULTI
#define MK_MULTI 0
#endif

#define LAS __attribute__((address_space(3)))
typedef unsigned short bf16_t;
typedef short bf16x8 __attribute__((ext_vector_type(8)));
typedef short s16x4 __attribute__((ext_vector_type(4)));
typedef float f32x4 __attribute__((ext_vector_type(4)));
typedef float f32x16 __attribute__((ext_vector_type(16)));
typedef unsigned u32x4 __attribute__((ext_vector_type(4)));
typedef unsigned u32x2 __attribute__((ext_vector_type(2)));
typedef float f32x2_t __attribute__((ext_vector_type(2)));
typedef __bf16 bf16x2_t __attribute__((ext_vector_type(2)));

constexpr int DM = 1024, BATCH = 4, SEQ = 4096, DEPTH = 4, M = BATCH * SEQ;
constexpr int NH = 16, NKV = 4, HD = 64, DFF = 2816, INTOT = 8704;
constexpr int LDP = 7680;
constexpr int PC_BA = 0, PC_UA = 1024, PC_UP = 2048, PC_Q = 3072, PC_K = 4096, PC_V = 4352, PC_G = 4608;
constexpr float EPS = 1e-6f;

constexpr size_t MiB = 1u << 20;
constexpr size_t WS_WIN = 0;
constexpr size_t WS_WA = 17 * MiB, WS_WT = 19 * MiB, WS_WO = 21 * MiB;
constexpr size_t WS_WP = 41 * MiB;
constexpr size_t WS_WGU = 24 * MiB;
constexpr size_t WS_WD = 35 * MiB;
constexpr size_t WS_PROJ = 48 * MiB;
constexpr size_t WS_HB = 288 * MiB;
constexpr size_t WS_ZA = 320 * MiB, WS_ZP = 352 * MiB, WS_ZT = 384 * MiB;
constexpr size_t WS_CTL = 416 * MiB, CTL_BYTES = 65536;
constexpr size_t WS_PART = 417 * MiB;
constexpr size_t WS_XB = WS_ZA;
constexpr size_t WS_WBUF1 = 418 * MiB;
constexpr size_t WS_END = 466 * MiB;

constexpr int LDS_BYTES = 147456;

__device__ __forceinline__ unsigned cvtpk(float lo, float hi) { f32x2_t v = {lo, hi}; bf16x2_t b = __builtin_convertvector(v, bf16x2_t); return __builtin_bit_cast(unsigned, b); }
__device__ __forceinline__ float bf_lo(unsigned u) { return __uint_as_float(u << 16); }
__device__ __forceinline__ float bf_hi(unsigned u) { return __uint_as_float(u & 0xffff0000u); }
__device__ __forceinline__ float sigmoidf_(float x) { return __builtin_amdgcn_rcpf(1.0f + __expf(-x)); }
#define LDS_WAIT() asm volatile("s_waitcnt lgkmcnt(0)" ::: "memory")
__device__ __forceinline__ void rstd8(const float* part, int row0, int fq, float (&rs)[2][4]) {
    f32x4 pv[2][4];
#pragma unroll
    for (int ai = 0; ai < 2; ++ai)
#pragma unroll
        for (int m = 0; m < 4; ++m) pv[ai][m] = *(const f32x4*)(part + (size_t)(row0 + ai * 128 + m * 16) * 16 + 4 * fq);
#pragma unroll
    for (int ai = 0; ai < 2; ++ai)
#pragma unroll
        for (int m = 0; m < 4; ++m) { float t = (pv[ai][m].x + pv[ai][m].y) + (pv[ai][m].z + pv[ai][m].w); t += __shfl_xor(t, 16); t += __shfl_xor(t, 32);
            rs[ai][m] = __builtin_amdgcn_rsqf(t * (1.0f / 1024.0f) + 1e-6f); }
}

namespace pg8 {
constexpr int BM = 256, BK = 64, HALF = 128, HTB = HALF * BK * 2, STAGE_BYTES = 8 * HTB, NXCD = 8, WGM = 8;
__host__ __device__ __forceinline__ int lds_byte(int r, int c) { const int st = (r >> 4) * 2 + (c >> 5), rr = r & 15, cc = c & 31, ob = rr * 64 + cc * 2; return st * 1024 + (ob ^ (((ob >> 9) & 1) << 5)); }
__host__ __device__ __forceinline__ void stage_rc(int b, int& R, int& C) { const int st = b / 1024, sb = b % 1024, swz = sb ^ (((sb >> 9) & 1) << 5); R = (st >> 1) * 16 + swz / 64; C = (st & 1) * 32 + (swz % 64) / 2; }
__host__ __device__ __forceinline__ int perm32(int rho) { const int n = rho >> 4, i = rho & 15; return 8 * (i >> 2) + 4 * n + (i & 3); }

struct Unit { int pm, pn, br; };
struct Gemm { const bf16_t* A; const bf16_t* Bt; int M, N, K, lda, ldb, agrp; const bf16_t* A1; const bf16_t* Bt1; int K1, agrp1; const bf16_t* A2; const bf16_t* Bt2; int K2, agrp2; };

struct StaticOrder {
    int nM, nN, nwg, G, c;
    __host__ __device__ void init(int M_, int N_, int G_, int c_) { nM = M_ / BM; nN = N_ / BM; nwg = nM * nN; G = G_; c = c_; }
    __host__ __device__ bool next(int i, Unit& u) const {
        const long L = (long)i * G + c; if (L >= nwg) return false;
        int wgid = (int)L; { const int q = nwg / NXCD, r = nwg % NXCD, xcd = wgid % NXCD, off = wgid / NXCD; wgid = (xcd < r ? xcd * (q + 1) : r * (q + 1) + (xcd - r) * q) + off; }
        const int nig = WGM * nN, gid = wgid / nig, fm = gid * WGM, gsz = (nM - fm) < WGM ? (nM - fm) : WGM;
        u.pm = fm + ((wgid % nig) % gsz); u.pn = (wgid % nig) / gsz; u.br = 0; return true;
    }
};
struct MergeOrder {
    StaticOrder base;
    __host__ __device__ __forceinline__ void init(int M_, int N_, int G_, int c_) { base.init(M_, N_, G_, c_); }
    __host__ __device__ __forceinline__ bool next(int i, Unit& u) const { const int q = i / 3, b = i - 3 * q; if (!base.next(q, u)) return false; u.br = b; return true; }
};


struct EpiProj {
    static constexpr bool PERM = true;
    bf16_t* O; const float* part;
    __device__ __forceinline__ void operator()(const f32x4 (&acc)[2][2][4][2], const Unit& u, int wr, int wc, int fr, int fq) const {
        const int row0 = u.pm * BM + wr * 64 + fr; const int pn = u.pn;
        float rsv[2][4]; rstd8(part, row0, fq, rsv);
        if (pn >= 4 && pn < 12) {
            const int col0 = PC_UA + 128 * (pn - 4) + wc * 32 + 8 * fq;
#pragma unroll
            for (int ai = 0; ai < 2; ++ai)
#pragma unroll
                for (int m = 0; m < 4; ++m) { bf16_t* rowp = O + (size_t)(row0 + ai * HALF + m * 16) * LDP + col0;
                    const float rs2 = rsv[ai][m] * rsv[ai][m];
                    const f32x4 v0 = acc[ai][0][m][0] * acc[ai][1][m][0] * rs2, v1 = acc[ai][0][m][1] * acc[ai][1][m][1] * rs2;
                    u32x4 w; w.x = cvtpk(v0[0], v0[1]); w.y = cvtpk(v0[2], v0[3]); w.z = cvtpk(v1[0], v1[1]); w.w = cvtpk(v1[2], v1[3]);
                    __builtin_nontemporal_store(w, (u32x4*)rowp); asm volatile("" ::: "memory"); }
        } else {
            const int colt = pn < 4 ? 256 * pn : 256 * pn - 1024; const int col0 = colt + wc * 32 + 8 * fq; const bool sig = pn >= 22;
#pragma unroll
            for (int ai = 0; ai < 2; ++ai)
#pragma unroll
                for (int m = 0; m < 4; ++m) { bf16_t* rowp = O + (size_t)(row0 + ai * HALF + m * 16) * LDP + col0;
                    const float rs = rsv[ai][m];
#pragma unroll
                    for (int bj = 0; bj < 2; ++bj) { f32x4 v0 = acc[ai][bj][m][0] * rs, v1 = acc[ai][bj][m][1] * rs;
                        if (sig) {
#pragma unroll
                            for (int e = 0; e < 4; ++e) { v0[e] = sigmoidf_(v0[e]); v1[e] = sigmoidf_(v1[e]); } }
                        u32x4 w; w.x = cvtpk(v0[0], v0[1]); w.y = cvtpk(v0[2], v0[3]); w.z = cvtpk(v1[0], v1[1]); w.w = cvtpk(v1[2], v1[3]);
                        __builtin_nontemporal_store(w, (u32x4*)(rowp + bj * HALF)); }
                    asm volatile("" ::: "memory"); }
        }
    }
};
struct EpiMerge {
    static constexpr bool PERM = true;
    bf16_t* Mg; const bf16_t* G0;
    __device__ __forceinline__ void operator()(const f32x4 (&acc)[2][2][4][2], const Unit& u, int wr, int wc, int fr, int fq) const {
        const int row0 = u.pm * BM + wr * 64 + fr; const int col0 = u.pn * BM + wc * 32 + 8 * fq;
        const bf16_t* G = G0 + u.br * DM; const bool first = (u.br == 0);
#pragma unroll
        for (int ai = 0; ai < 2; ++ai)
#pragma unroll
            for (int m = 0; m < 4; ++m) { const size_t row = (size_t)(row0 + ai * HALF + m * 16);
#pragma unroll
                for (int bj = 0; bj < 2; ++bj) {
                    const u32x4 g = *(const u32x4*)(G + row * LDP + col0 + bj * HALF);
                    f32x4 v0 = acc[ai][bj][m][0], v1 = acc[ai][bj][m][1];
                    v0[0] *= bf_lo(g.x); v0[1] *= bf_hi(g.x); v0[2] *= bf_lo(g.y); v0[3] *= bf_hi(g.y);
                    v1[0] *= bf_lo(g.z); v1[1] *= bf_hi(g.z); v1[2] *= bf_lo(g.w); v1[3] *= bf_hi(g.w);
                    bf16_t* op = Mg + row * DM + col0 + bj * HALF;
                    if (!first) { const u32x4 o = *(const u32x4*)op;
                        v0[0] += bf_lo(o.x); v0[1] += bf_hi(o.x); v0[2] += bf_lo(o.y); v0[3] += bf_hi(o.y);
                        v1[0] += bf_lo(o.z); v1[1] += bf_hi(o.z); v1[2] += bf_lo(o.w); v1[3] += bf_hi(o.w); }
                    u32x4 w; w.x = cvtpk(v0[0], v0[1]); w.y = cvtpk(v0[2], v0[3]); w.z = cvtpk(v1[0], v1[1]); w.w = cvtpk(v1[2], v1[3]);
                    *(u32x4*)op = w; }
                asm volatile("" ::: "memory"); }
    }
};
struct EpiResid {
    static constexpr bool PERM = true;
    const float* base; float* out; bf16_t* xb; float* part;
    __device__ __forceinline__ void operator()(const f32x4 (&acc)[2][2][4][2], const Unit& u, int wr, int wc, int fr, int fq) const {
        const int row0 = u.pm * BM + wr * 64 + fr; const int col0 = u.pn * BM + wc * 32 + 8 * fq;
#pragma unroll
        for (int ai = 0; ai < 2; ++ai)
#pragma unroll
            for (int m = 0; m < 4; ++m) { const int row = row0 + ai * HALF + m * 16; const size_t off = (size_t)row * DM + col0; float ss = 0.f;
#pragma unroll
                for (int bj = 0; bj < 2; ++bj) {
                    const f32x4 x0 = *(const f32x4*)(base + off + bj * HALF) + acc[ai][bj][m][0], x1 = *(const f32x4*)(base + off + bj * HALF + 4) + acc[ai][bj][m][1];
                    *(f32x4*)(out + off + bj * HALF) = x0; *(f32x4*)(out + off + bj * HALF + 4) = x1;
                    ss += ((x0[0] * x0[0] + x0[1] * x0[1]) + (x0[2] * x0[2] + x0[3] * x0[3])) + ((x1[0] * x1[0] + x1[1] * x1[1]) + (x1[2] * x1[2] + x1[3] * x1[3]));
                    u32x4 w; w.x = cvtpk(x0[0], x0[1]); w.y = cvtpk(x0[2], x0[3]); w.z = cvtpk(x1[0], x1[1]); w.w = cvtpk(x1[2], x1[3]);
                    *(u32x4*)(xb + off + bj * HALF) = w; }
                ss += __shfl_xor(ss, 16); ss += __shfl_xor(ss, 32);
                if (fq == 0) part[(size_t)row * 16 + u.pn * 4 + wc] = ss;
                asm volatile("" ::: "memory"); }
    }
};
struct EpiAct {
    static constexpr bool PERM = true;
    bf16_t* O; const float* part;
    __device__ __forceinline__ void operator()(const f32x4 (&acc)[2][2][4][2], const Unit& u, int wr, int wc, int fr, int fq) const {
        const int row0 = u.pm * BM + wr * 64 + fr; const int col0 = 128 * u.pn + wc * 32 + 8 * fq;
        float rsv[2][4]; rstd8(part, row0, fq, rsv);
#pragma unroll
        for (int ai = 0; ai < 2; ++ai)
#pragma unroll
            for (int m = 0; m < 4; ++m) { bf16_t* rowp = O + (size_t)(row0 + ai * HALF + m * 16) * DFF + col0;
                const float rs = rsv[ai][m];
                f32x4 v0, v1;
#pragma unroll
                for (int e = 0; e < 4; ++e) { const float g0 = acc[ai][0][m][0][e] * rs, g1 = acc[ai][0][m][1][e] * rs;
                    v0[e] = g0 * sigmoidf_(g0) * (acc[ai][1][m][0][e] * rs); v1[e] = g1 * sigmoidf_(g1) * (acc[ai][1][m][1][e] * rs); }
                u32x4 w; w.x = cvtpk(v0[0], v0[1]); w.y = cvtpk(v0[2], v0[3]); w.z = cvtpk(v1[0], v1[1]); w.w = cvtpk(v1[2], v1[3]);
                __builtin_nontemporal_store(w, (u32x4*)rowp); asm volatile("" ::: "memory"); }
    }
};

template <class Epi, class Sched, bool ALIGN_EPI = true>
__device__ __forceinline__ void gemm_phase(LAS unsigned char* lds, const Gemm g, const Sched& S, const Epi& E) {
    int tid = threadIdx.x; asm volatile("" : "+v"(tid));
    const int wid = __builtin_amdgcn_readfirstlane(tid >> 6), lane = tid & 63, wr = wid >> 2, wc = wid & 3, fr = lane & 15, fq = lane >> 4;
    int nt = g.K / BK;
    unsigned voffA[2], voffB[2];
#pragma unroll
    for (int i = 0; i < 2; ++i) { int R, C; stage_rc(tid * 16 + i * 8192, R, C); const int Rb = Epi::PERM ? ((R & ~31) + perm32(R & 31)) : R;
        voffA[i] = (unsigned)(R * g.lda + C) * 2u; voffB[i] = (unsigned)(Rb * g.ldb + C) * 2u; }
    const size_t kstep = (size_t)(BK * 2);
    const size_t hstepA = (size_t)HALF * g.lda * 2, hstepB = (size_t)HALF * g.ldb * 2;
    const size_t tstepA = 2 * hstepA, tstepB = 2 * hstepB;
#define PG8_ABASE(u) ((u).br == 0 ? (const char*)g.A + (size_t)(u).pm * tstepA + (g.agrp ? (size_t)(u).pn * 512 : (size_t)0) : (u).br == 1 ? (const char*)g.A1 + (size_t)(u).pm * tstepA + (g.agrp1 ? (size_t)(u).pn * 512 : (size_t)0) : (const char*)g.A2 + (size_t)(u).pm * tstepA + (g.agrp2 ? (size_t)(u).pn * 512 : (size_t)0))
#define PG8_BBASE(u) (((u).br == 0 ? (const char*)g.Bt : (u).br == 1 ? (const char*)g.Bt1 : (const char*)g.Bt2) + (size_t)(u).pn * tstepB)
#define PG8_NT(u) (((u).br == 0 ? g.K : (u).br == 1 ? g.K1 : g.K2) / BK)
    const unsigned ldsw = (unsigned)wid * 1024u;
    const int aoff = lds_byte(wr * 64 + fr, fq * 8), boff = lds_byte(wc * 32 + fr, fq * 8);
#define PG8_SA(b, h) (((b) * 2 + (h)) * HTB)
#define PG8_SB(b, h) ((4 + (b) * 2 + (h)) * HTB)
#define PG8_STAGE(bufoff, gbase, voff) do { _Pragma("unroll") for (int _i = 0; _i < 2; ++_i) \
        __builtin_amdgcn_global_load_lds((const unsigned*)((const char*)(gbase) + (voff)[_i]), (LAS unsigned*)(lds + (bufoff) + ldsw + _i * 8192), 16, 0, 0); } while (0)
#define PG8_LDA(dst, b, h) do { _Pragma("unroll") for (int m = 0; m < 4; ++m) _Pragma("unroll") for (int k = 0; k < 2; ++k) dst[m][k] = *(const LAS bf16x8*)(lds + PG8_SA(b, h) + aoff + m * 2048 + k * 1024); } while (0)
#define PG8_LDB(dst, b, h) do { _Pragma("unroll") for (int n = 0; n < 2; ++n) _Pragma("unroll") for (int k = 0; k < 2; ++k) dst[n][k] = *(const LAS bf16x8*)(lds + PG8_SB(b, h) + boff + n * 2048 + k * 1024); } while (0)
#define PG8_MMA(ai, bj, At, Bt) do { __builtin_amdgcn_s_setprio(1); _Pragma("unroll") for (int m = 0; m < 4; ++m) _Pragma("unroll") for (int n = 0; n < 2; ++n) _Pragma("unroll") for (int k = 0; k < 2; ++k) \
        acc[ai][bj][m][n] = __builtin_amdgcn_mfma_f32_16x16x32_bf16(Bt[n][k], At[m][k], acc[ai][bj][m][n], 0, 0, 0); __builtin_amdgcn_s_setprio(0); } while (0)
#define PG8_WAIT_V(n) asm volatile("s_waitcnt vmcnt(" #n ")" ::: "memory")
#define PG8_WAIT_L(n) asm volatile("s_waitcnt lgkmcnt(" #n ")" ::: "memory")
#define PG8_BAR __builtin_amdgcn_s_barrier()
#define PG8_SCHED __builtin_amdgcn_sched_barrier(0)
    Unit cur, nxt; int ui = 0;
    if (!S.next(0, cur)) return;
    f32x4 acc[2][2][4][2];
#pragma unroll
    for (int a = 0; a < 2; ++a)
#pragma unroll
        for (int b = 0; b < 2; ++b)
#pragma unroll
            for (int m = 0; m < 4; ++m)
#pragma unroll
                for (int n = 0; n < 2; ++n) acc[a][b][m][n] = (f32x4){0.f, 0.f, 0.f, 0.f};
    bf16x8 At[4][2], B0[2][2], B1[2][2];
    const char* cA = PG8_ABASE(cur); const char* cB = PG8_BBASE(cur); nt = PG8_NT(cur);
    PG8_STAGE(PG8_SB(0, 0), cB, voffB); PG8_STAGE(PG8_SB(0, 1), cB + hstepB, voffB); PG8_STAGE(PG8_SA(0, 0), cA, voffA); PG8_STAGE(PG8_SA(0, 1), cA + hstepA, voffA);
    if (wr == 1) PG8_BAR;
    PG8_WAIT_V(2); PG8_BAR;
    PG8_STAGE(PG8_SB(1, 0), cB + kstep, voffB); PG8_STAGE(PG8_SA(1, 0), cA + kstep, voffA); PG8_STAGE(PG8_SB(1, 1), cB + hstepB + kstep, voffB);
    PG8_WAIT_V(6); PG8_BAR;
    for (;;) {
        const bool has_next = S.next(ui + 1, nxt);
        const char* nA = has_next ? PG8_ABASE(nxt) : cA; const char* nB = has_next ? PG8_BBASE(nxt) : cB;
        for (int t = 0; t < nt; t += 2) {
            const bool last = (t == nt - 2);
            const char* a1 = cA + (size_t)(t + 1) * kstep;
            const char* a2 = last ? nA : cA + (size_t)(t + 2) * kstep; const char* b2 = last ? nB : cB + (size_t)(t + 2) * kstep;
            const char* a3 = a2 + kstep; const char* b3 = b2 + kstep;
            PG8_LDB(B0, 0, 0); PG8_LDB(B1, 0, 1); PG8_SCHED; PG8_LDA(At, 0, 0); PG8_STAGE(PG8_SA(1, 1), a1 + hstepA, voffA);
            PG8_WAIT_V(8); PG8_WAIT_L(0); PG8_BAR; PG8_MMA(0, 0, At, B0); PG8_MMA(0, 1, At, B1); PG8_BAR; PG8_SCHED;
            PG8_LDA(At, 0, 1); PG8_STAGE(PG8_SB(0, 0), b2, voffB); PG8_STAGE(PG8_SB(0, 1), b2 + hstepB, voffB); PG8_STAGE(PG8_SA(0, 0), a2, voffA);
            PG8_WAIT_V(8); PG8_WAIT_L(0); PG8_BAR; PG8_MMA(1, 0, At, B0); PG8_MMA(1, 1, At, B1); PG8_BAR; PG8_SCHED;
            PG8_LDB(B0, 1, 0); PG8_LDB(B1, 1, 1); PG8_SCHED; PG8_LDA(At, 1, 0); PG8_STAGE(PG8_SA(0, 1), a2 + hstepA, voffA);
            PG8_WAIT_V(8); PG8_WAIT_L(0); PG8_BAR; PG8_MMA(0, 0, At, B0); PG8_MMA(0, 1, At, B1); PG8_BAR; PG8_SCHED;
            PG8_LDA(At, 1, 1); PG8_STAGE(PG8_SB(1, 0), b3, voffB); PG8_STAGE(PG8_SB(1, 1), b3 + hstepB, voffB); PG8_STAGE(PG8_SA(1, 0), a3, voffA);
            PG8_WAIT_V(8); PG8_WAIT_L(0); PG8_BAR; PG8_MMA(1, 0, At, B0); PG8_MMA(1, 1, At, B1); PG8_BAR; PG8_SCHED;
        }
        if constexpr (ALIGN_EPI) { if (wr == 0) PG8_BAR; }
        E(acc, cur, wr, wc, fr, fq);
        if (!has_next) break;
#pragma unroll
        for (int a = 0; a < 2; ++a)
#pragma unroll
            for (int b = 0; b < 2; ++b)
#pragma unroll
                for (int m = 0; m < 4; ++m)
#pragma unroll
                    for (int n = 0; n < 2; ++n) acc[a][b][m][n] = (f32x4){0.f, 0.f, 0.f, 0.f};
        cur = nxt; cA = nA; cB = nB; ++ui; nt = PG8_NT(cur);
        if constexpr (ALIGN_EPI) { if (wr == 1) PG8_BAR; }
    }
    PG8_WAIT_V(0);
    if constexpr (!ALIGN_EPI) { if (wr == 0) PG8_BAR; }
    PG8_BAR;
#undef PG8_ABASE
#undef PG8_BBASE
#undef PG8_NT
#undef PG8_SA
#undef PG8_SB
#undef PG8_STAGE
#undef PG8_LDA
#undef PG8_LDB
#undef PG8_MMA
#undef PG8_WAIT_V
#undef PG8_WAIT_L
#undef PG8_BAR
#undef PG8_SCHED
}
}

struct Args {
    const float* x; const float* w_in; const float* conv_w; const float* w_a_out; const float* w_pool; const float* pool_scale;
    const float* w_attn_out; const float* attn_sink; const float* w_o; const float* g_mix; const float* g_ffn; const float* w_gu;
    const float* w_down; const float* rel_bias; const float* g_final;
    float* out; unsigned char* ws; int ph_lo, ph_hi;
};

struct CvtItem { const float* src; bf16_t* dst; const float* nscale; const float* kscale; int N, ldt; };
__device__ __forceinline__ int map_win(int n0) {
    if (n0 >= 1024 && n0 < 2048) { const int j = n0 - 1024; return 1024 + (j >> 7) * 256 + (j & 127); }
    if (n0 >= 2048 && n0 < 3072) { const int j = n0 - 2048; return 1024 + (j >> 7) * 256 + 128 + (j & 127); }
    return n0;
}
__device__ __forceinline__ int map_wgu(int n0) {
    if (n0 < DFF) return (n0 >> 7) * 256 + (n0 & 127);
    const int j = n0 - DFF; return (j >> 7) * 256 + 128 + (j & 127);
}
constexpr int IT_WIN = 16 * 272, IT_SQ = 16 * 32, IT_POOL = 4 * 32, IT_WGU = 16 * 176, IT_WD = 44 * 32;
constexpr int IT_TOTAL = IT_WIN + 3 * IT_SQ + IT_POOL + IT_WGU + IT_WD;
constexpr int IT_SPLIT = IT_WIN + IT_SQ + IT_POOL;
__device__ __forceinline__ CvtItem cvt_mk(const float* W, int N, bf16_t* WT, int ldt, int k0, int n0, int drow0, const float* nscale, const float* kscale) {
    CvtItem d; d.src = W + (size_t)k0 * N + n0; d.dst = WT + (size_t)drow0 * ldt + k0; d.nscale = nscale ? nscale + n0 : nullptr; d.kscale = kscale ? kscale + k0 : nullptr; d.N = N; d.ldt = ldt; return d;
}
__device__ __forceinline__ CvtItem cvt_decode(const Args& a, int l, unsigned char* ws, int it) {
    int r = it;
    if (r < IT_WIN) { const int kb = r / 272, nb = r % 272; return cvt_mk(a.w_in + (size_t)l * DM * INTOT, INTOT, (bf16_t*)(ws + WS_WIN), DM, 64 * kb, 32 * nb, map_win(32 * nb), nullptr, a.g_mix + (size_t)l * DM); } r -= IT_WIN;
    if (r < IT_SQ) { const int kb = r / 32, nb = r % 32; return cvt_mk(a.w_a_out + (size_t)l * DM * DM, DM, (bf16_t*)(ws + WS_WA), DM, 64 * kb, 32 * nb, 32 * nb, nullptr, nullptr); } r -= IT_SQ;
    if (r < IT_POOL) { const int gi = r / 32, q = r % 32, kb = q / 8, nb = q % 8;
        return cvt_mk(a.w_pool + (size_t)l * 4 * 65536 + (size_t)gi * 65536, 256, (bf16_t*)(ws + WS_WP) + (size_t)gi * 256 * 1024, 1024, 64 * kb, 32 * nb, 32 * nb, a.pool_scale + (size_t)l * DM + gi * 256, nullptr); } r -= IT_POOL;
    if (r < IT_SQ) { const int kb = r / 32, nb = r % 32; return cvt_mk(a.w_attn_out + (size_t)l * DM * DM, DM, (bf16_t*)(ws + WS_WT), DM, 64 * kb, 32 * nb, 32 * nb, nullptr, nullptr); } r -= IT_SQ;
    if (r < IT_SQ) { const int kb = r / 32, nb = r % 32; return cvt_mk(a.w_o + (size_t)l * DM * DM, DM, (bf16_t*)(ws + WS_WO), DM, 64 * kb, 32 * nb, 32 * nb, nullptr, nullptr); } r -= IT_SQ;
    if (r < IT_WGU) { const int kb = r / 176, nb = r % 176; return cvt_mk(a.w_gu + (size_t)l * DM * 2 * DFF, 2 * DFF, (bf16_t*)(ws + WS_WGU), DM, 64 * kb, 32 * nb, map_wgu(32 * nb), nullptr, a.g_ffn + (size_t)l * DM); } r -= IT_WGU;
    { const int kb = r / 32, nb = r % 32; return cvt_mk(a.w_down + (size_t)l * DFF * DM, DM, (bf16_t*)(ws + WS_WD), DFF, 64 * kb, 32 * nb, 32 * nb, nullptr, nullptr); }
}
__device__ __forceinline__ void cvt_load(const CvtItem& d, int lane, f32x4 (&v)[8]) {
    const float* p = d.src + (size_t)(lane >> 3) * d.N + 4 * (lane & 7);
#pragma unroll
    for (int i = 0; i < 8; ++i) v[i] = __builtin_nontemporal_load((const f32x4*)(p + (size_t)(8 * i) * d.N));
}
__device__ __forceinline__ void cvt_lds_write(LAS float* scr, int lane, const f32x4 (&v)[8]) {
    LAS float* q = scr + (lane >> 3) * 33 + 4 * (lane & 7);
#pragma unroll
    for (int i = 0; i < 8; ++i) { q[(8 * i) * 33 + 0] = v[i].x; q[(8 * i) * 33 + 1] = v[i].y; q[(8 * i) * 33 + 2] = v[i].z; q[(8 * i) * 33 + 3] = v[i].w; }
}
__device__ __forceinline__ void cvt_store(const CvtItem& d, const LAS float* scr, int lane) {
    const int c = lane & 7;
    f32x4 ka = (f32x4){1.f, 1.f, 1.f, 1.f}, kb = ka;
    if (d.kscale) { ka = *(const f32x4*)(d.kscale + 8 * c); kb = *(const f32x4*)(d.kscale + 8 * c + 4); }
#pragma unroll
    for (int j = 0; j < 4; ++j) { const int n = (lane >> 3) + 8 * j; const LAS float* s = scr + (8 * c) * 33 + n;
        const float sc = d.nscale ? d.nscale[n] : 1.0f;
        u32x4 o; o.x = cvtpk(s[0 * 33] * (sc * ka[0]), s[1 * 33] * (sc * ka[1])); o.y = cvtpk(s[2 * 33] * (sc * ka[2]), s[3 * 33] * (sc * ka[3])); o.z = cvtpk(s[4 * 33] * (sc * kb[0]), s[5 * 33] * (sc * kb[1])); o.w = cvtpk(s[6 * 33] * (sc * kb[2]), s[7 * 33] * (sc * kb[3]));
        *(u32x4*)(d.dst + (size_t)n * d.ldt + 8 * c) = o; }
}
__device__ __forceinline__ void convert_weights(const Args& a, int l, LAS float* scr, int gw, int ngw, int lane, int it_lo, int it_hi) {
    unsigned char* ws = a.ws + ((l & 1) ? WS_WBUF1 : (size_t)0);
    int it = it_lo + gw; if (it >= it_hi) return;
    CvtItem cur = cvt_decode(a, l, ws, it); f32x4 v[8]; cvt_load(cur, lane, v);
    for (;;) {
        cvt_lds_write(scr, lane, v);
        const int nit = it + ngw; const bool has = nit < it_hi; CvtItem nx = cur;
        if (has) { nx = cvt_decode(a, l, ws, nit); cvt_load(nx, lane, v); }
        LDS_WAIT(); asm volatile("" ::: "memory");
        cvt_store(cur, scr, lane);
        LDS_WAIT(); asm volatile("" ::: "memory");
        if (!has) break;
        cur = nx; it = nit;
    }
}
__device__ __forceinline__ void convert_in_tail(const Args& a, int lnext, LAS unsigned char* lds, int nwg, int G, int bx, int it_lo, int it_hi) {
    int tid = threadIdx.x; asm volatile("" : "+v"(tid));
    const int lane = tid & 63, wave = __builtin_amdgcn_readfirstlane(tid >> 6);
    const int tail = nwg % G;
    if (tail == 0) convert_weights(a, lnext, (LAS float*)(lds + wave * 16384), bx * 8 + wave, G * 8, lane, it_lo, it_hi);
    else if (bx >= tail) convert_weights(a, lnext, (LAS float*)(lds + wave * 16384), (bx - tail) * 8 + wave, (G - tail) * 8, lane, it_lo, it_hi);
}

__device__ __forceinline__ float wave_sum(float v) {
#pragma unroll
    for (int o = 1; o < 64; o <<= 1) v += __shfl_xor(v, o);
    return v;
}
__device__ __forceinline__ void rms_row_bf16(const float* xrow, const float* g, bf16_t* orow, int lane) {
    const f32x4* xr = (const f32x4*)xrow + lane; const f32x4* gr = (const f32x4*)g + lane;
    f32x4 v[4]; float s = 0.f;
#pragma unroll
    for (int j = 0; j < 4; ++j) { v[j] = xr[64 * j]; s += (v[j].x * v[j].x + v[j].y * v[j].y) + (v[j].z * v[j].z + v[j].w * v[j].w); }
    const float rstd = 1.0f / sqrtf(wave_sum(s) * (1.0f / DM) + EPS);
    u32x2* o8 = (u32x2*)orow + lane;
#pragma unroll
    for (int j = 0; j < 4; ++j) { const f32x4 gg = gr[64 * j]; u32x2 w; w.x = cvtpk(v[j].x * rstd * gg.x, v[j].y * rstd * gg.y); w.y = cvtpk(v[j].z * rstd * gg.z, v[j].w * rstd * gg.w); o8[64 * j] = w; }
}
__device__ __forceinline__ void prep_row(const float* xrow, bf16_t* orow, float* prow, int lane) {
    const f32x4* xr = (const f32x4*)xrow + lane;
    f32x4 v[4]; float s = 0.f;
#pragma unroll
    for (int j = 0; j < 4; ++j) { v[j] = xr[64 * j]; s += (v[j].x * v[j].x + v[j].y * v[j].y) + (v[j].z * v[j].z + v[j].w * v[j].w); }
    s = wave_sum(s);
    u32x2* o8 = (u32x2*)orow + lane;
#pragma unroll
    for (int j = 0; j < 4; ++j) { u32x2 w; w.x = cvtpk(v[j].x, v[j].y); w.y = cvtpk(v[j].z, v[j].w); o8[64 * j] = w; }
    if (lane < 16) prow[lane] = lane == 0 ? s : 0.f;
}
__device__ __forceinline__ void rms_row_f32(const float* xrow, const float* g, float* orow, int lane) {
    const f32x4* xr = (const f32x4*)xrow + lane; const f32x4* gr = (const f32x4*)g + lane;
    f32x4 v[4]; float s = 0.f;
#pragma unroll
    for (int j = 0; j < 4; ++j) { v[j] = xr[64 * j]; s += (v[j].x * v[j].x + v[j].y * v[j].y) + (v[j].z * v[j].z + v[j].w * v[j].w); }
    const float rstd = 1.0f / sqrtf(wave_sum(s) * (1.0f / DM) + EPS);
    f32x4* o = (f32x4*)orow + lane;
#pragma unroll
    for (int j = 0; j < 4; ++j) { const f32x4 gg = gr[64 * j]; o[64 * j] = v[j] * rstd * gg; }
}

__device__ __forceinline__ void unpack8(const u32x4 v, float (&f)[8]) {
    f[0] = bf_lo(v.x); f[1] = bf_hi(v.x); f[2] = bf_lo(v.y); f[3] = bf_hi(v.y); f[4] = bf_lo(v.z); f[5] = bf_hi(v.z); f[6] = bf_lo(v.w); f[7] = bf_hi(v.w);
}
__device__ __forceinline__ void store8(bf16_t* p, const float (&f)[8]) {
    u32x4 w; w.x = cvtpk(f[0], f[1]); w.y = cvtpk(f[2], f[3]); w.z = cvtpk(f[4], f[5]); w.w = cvtpk(f[6], f[7]); *(u32x4*)p = w;
}
__device__ __forceinline__ void conv_item(const bf16_t* P, bf16_t* ZA, const float* cw, int m0, int ch) {
    const int t0 = m0 & (SEQ - 1);
    u32x4 U[10], B[8];
#pragma unroll
    for (int j = 0; j < 10; ++j) { const int t = t0 - 1 + j; U[j] = (u32x4){0u, 0u, 0u, 0u}; if ((unsigned)t < (unsigned)SEQ) U[j] = *(const u32x4*)(P + (size_t)(m0 - 1 + j) * LDP + PC_UA + ch); }
#pragma unroll
    for (int i = 0; i < 8; ++i) B[i] = *(const u32x4*)(P + (size_t)(m0 + i) * LDP + PC_BA + ch);
    float w0[8], w1[8], w2[8];
#pragma unroll
    for (int e = 0; e < 8; ++e) { w0[e] = cw[ch + e]; w1[e] = cw[DM + ch + e]; w2[e] = cw[2 * DM + ch + e]; }
    float up[8], uc[8], un[8], bb[8], o[8];
    unpack8(U[0], up); unpack8(U[1], uc);
#pragma unroll
    for (int i = 0; i < 8; ++i) { unpack8(U[i + 2], un); unpack8(B[i], bb);
#pragma unroll
        for (int e = 0; e < 8; ++e) { o[e] = bb[e] * (w0[e] * up[e] + w1[e] * uc[e] + w2[e] * un[e]); up[e] = uc[e]; uc[e] = un[e]; }
        store8(ZA + (size_t)(m0 + i) * DM + ch, o); }
}
template <int W> __device__ __forceinline__ void pool_item(const bf16_t* P, bf16_t* ZP, int m0, int ch) {
    constexpr int NL = W + 7, H = W / 2;
    const int t0 = m0 & (SEQ - 1);
    u32x4 L[NL];
#pragma unroll
    for (int j = 0; j < NL; ++j) { const int t = t0 - H + j; L[j] = (u32x4){0u, 0u, 0u, 0u}; if ((unsigned)t < (unsigned)SEQ) L[j] = *(const u32x4*)(P + (size_t)(m0 - H + j) * LDP + PC_UP + ch); }
    float sum[8], tmp[8], o[8];
#pragma unroll
    for (int e = 0; e < 8; ++e) sum[e] = 0.f;
#pragma unroll
    for (int j = 0; j < W; ++j) { unpack8(L[j], tmp);
#pragma unroll
        for (int e = 0; e < 8; ++e) sum[e] += tmp[e]; }
#pragma unroll
    for (int i = 0; i < 8; ++i) {
        if (i > 0) { unpack8(L[W - 1 + i], tmp);
#pragma unroll
            for (int e = 0; e < 8; ++e) sum[e] += tmp[e];
            unpack8(L[i - 1], tmp);
#pragma unroll
            for (int e = 0; e < 8; ++e) sum[e] -= tmp[e]; }
        const int t = t0 + i, lo = (t - H) > 0 ? (t - H) : 0, hi = (t + H - 1) < SEQ - 1 ? (t + H - 1) : SEQ - 1;
        const float inv = 1.0f / (float)(hi - lo + 1);
        unpack8(L[H + i], tmp);
#pragma unroll
        for (int e = 0; e < 8; ++e) o[e] = sum[e] * inv - tmp[e];
        store8(ZP + (size_t)(m0 + i) * DM + ch, o); }
}
__device__ __forceinline__ void convpool_phase(const Args& a, int l, int gwv, int ngw, int lane) {
    const bf16_t* P = (const bf16_t*)(a.ws + WS_PROJ);
    bf16_t* ZA = (bf16_t*)(a.ws + WS_ZA); bf16_t* ZP = (bf16_t*)(a.ws + WS_ZP);
    const float* cw = a.conv_w + (size_t)l * 3 * DM;
    for (int ci = gwv; ci < (M / 8) * 2; ci += ngw) conv_item(P, ZA, cw, (ci >> 1) * 8, ((ci & 1) * 64 + lane) * 8);
    for (int wi = gwv; wi < (M / 16) * 4; wi += ngw) { const int gi = wi & 3, m0 = ((wi >> 2) * 2 + (lane >> 5)) * 8, ch = (32 * gi + (lane & 31)) * 8;
        if (gi == 0) pool_item<2>(P, ZP, m0, ch); else if (gi == 1) pool_item<4>(P, ZP, m0, ch); else if (gi == 2) pool_item<8>(P, ZP, m0, ch); else pool_item<16>(P, ZP, m0, ch); }
}

constexpr int AT_KP = 144;
constexpr int AT_K = 0, AT_V = 384 * AT_KP, AT_B = AT_V + 384 * AT_KP, AT_BP = 320;
static_assert(AT_B + 16 * AT_BP * 4 <= 131072, "attention LDS");
constexpr float LOG2E = 1.4426950408889634f;
__device__ __forceinline__ int crow(int reg, int h) { return (reg & 3) + 8 * (reg >> 2) + 4 * h; }
__device__ __forceinline__ int t5_bucket(int rel) {
    const int n = rel < 0 ? -rel : rel;
    const int b = n < 8 ? n : n < 12 ? 8 : n < 16 ? 9 : n < 23 ? 10 : n < 32 ? 11 : n < 46 ? 12 : n < 64 ? 13 : n < 91 ? 14 : 15;
    return (rel > 0 ? 16 : 0) + b;
}
#define MFMA32(a, b, c) __builtin_amdgcn_mfma_f32_32x32x16_bf16((a), (b), (c), 0, 0, 0)

typedef short v4i16_t __attribute__((ext_vector_type(4)));
__device__ __forceinline__ s16x4 vtr(const LAS unsigned char* p) { return __builtin_bit_cast(s16x4, __builtin_amdgcn_ds_read_tr16_b64_v4i16((LAS v4i16_t*)p)); }
__device__ __forceinline__ void attn_qtile(const LAS unsigned char* lds, const LAS float* bt, const bf16x8 (&qf)[4], int lane, int r, int hh, int qrel, int t0, int tlo, int thi, float sink8, bf16_t* orow) {
    const float C2 = 0.125f * LOG2E;
    float mrun = sink8, lrun = 0.f;
    f32x16 o0, o1;
#pragma unroll
    for (int i = 0; i < 16; ++i) { o0[i] = 0.f; o1[i] = 0.f; }
#pragma unroll 1
    for (int c = 0; c < 3; ++c) {
        f32x16 s[3];
#pragma unroll
        for (int tt = 0; tt < 3; ++tt) { const int kvt = t0 + 3 * c + tt;
            const LAS float* bp = bt + (32 * kvt - qrel + 4 * hh + 32);
#pragma unroll
            for (int i = 0; i < 16; ++i) s[tt][i] = bp[(i & 3) + 8 * (i >> 2)];
            const LAS unsigned char* kp = lds + AT_K + (kvt * 32 + r) * AT_KP + hh * 16;
#pragma unroll
            for (int ds = 0; ds < 4; ++ds) { const bf16x8 kf = *(const LAS bf16x8*)(kp + ds * 32); s[tt] = MFMA32(kf, qf[ds], s[tt]); } }
        float cm = -INFINITY;
#pragma unroll
        for (int tt = 0; tt < 3; ++tt) { const int kvt = t0 + 3 * c + tt; const bool tinv = (kvt < tlo) || (kvt >= thi);
#pragma unroll
            for (int i = 0; i < 16; ++i) { if (tinv) s[tt][i] = -INFINITY; cm = fmaxf(cm, s[tt][i]); } }
        { auto rr = __builtin_amdgcn_permlane32_swap(__float_as_uint(cm), __float_as_uint(cm), false, false); cm = fmaxf(__uint_as_float(rr[0]), __uint_as_float(rr[1])); }
        const float mnew = fmaxf(mrun, cm), alpha = __builtin_amdgcn_exp2f((mrun - mnew) * C2), nm = -mnew * C2;
        float ps0 = 0.f, ps1 = 0.f;
#pragma unroll
        for (int tt = 0; tt < 3; ++tt)
#pragma unroll
            for (int i = 0; i < 16; i += 2) { const float p0 = __builtin_amdgcn_exp2f(__builtin_fmaf(s[tt][i], C2, nm)), p1 = __builtin_amdgcn_exp2f(__builtin_fmaf(s[tt][i + 1], C2, nm)); s[tt][i] = p0; s[tt][i + 1] = p1; ps0 += p0; ps1 += p1; }
        lrun = lrun * alpha + (ps0 + ps1); mrun = mnew;
#pragma unroll
        for (int i = 0; i < 16; ++i) { o0[i] *= alpha; o1[i] *= alpha; }
#pragma unroll
        for (int tt = 0; tt < 3; ++tt) { const int kvt = t0 + 3 * c + tt;
#pragma unroll
            for (int st = 0; st < 2; ++st) {
                u32x4 pw; pw.x = cvtpk(s[tt][8 * st + 0], s[tt][8 * st + 1]); pw.y = cvtpk(s[tt][8 * st + 2], s[tt][8 * st + 3]);
                pw.z = cvtpk(s[tt][8 * st + 4], s[tt][8 * st + 5]); pw.w = cvtpk(s[tt][8 * st + 6], s[tt][8 * st + 7]);
                const bf16x8 pk = __builtin_bit_cast(bf16x8, pw);
                const LAS unsigned char* vp = lds + AT_V + (32 * kvt + 16 * st + 4 * hh + ((lane & 15) >> 2)) * AT_KP + 32 * ((lane >> 4) & 1) + 8 * (lane & 3);
                { const s16x4 lo = vtr(vp), hi = vtr(vp + 8 * AT_KP);
                  const bf16x8 vf = __builtin_shufflevector(lo, hi, 0, 1, 2, 3, 4, 5, 6, 7); o0 = MFMA32(vf, pk, o0); }
                { const s16x4 lo = vtr(vp + 64), hi = vtr(vp + 64 + 8 * AT_KP);
                  const bf16x8 vf = __builtin_shufflevector(lo, hi, 0, 1, 2, 3, 4, 5, 6, 7); o1 = MFMA32(vf, pk, o1); }
            } }
    }
    lrun += __shfl_xor(lrun, 32);
    lrun += __builtin_amdgcn_exp2f((sink8 - mrun) * C2);
    const float inv = 1.0f / lrun;
#pragma unroll
    for (int g4 = 0; g4 < 4; ++g4) {
        u32x2 w0, w1;
        w0.x = cvtpk(o0[4 * g4 + 0] * inv, o0[4 * g4 + 1] * inv); w0.y = cvtpk(o0[4 * g4 + 2] * inv, o0[4 * g4 + 3] * inv);
        w1.x = cvtpk(o1[4 * g4 + 0] * inv, o1[4 * g4 + 1] * inv); w1.y = cvtpk(o1[4 * g4 + 2] * inv, o1[4 * g4 + 3] * inv);
        *(u32x2*)(orow + 8 * g4 + 4 * hh) = w0; *(u32x2*)(orow + 32 + 8 * g4 + 4 * hh) = w1; }
}

__device__ __forceinline__ void attn_unit(const Args& a, int l, int unit, LAS unsigned char* lds) {
    int tid = threadIdx.x; asm volatile("" : "+v"(tid));
    const int lane = tid & 63, wid = __builtin_amdgcn_readfirstlane(tid >> 6), r = lane & 31, hh = lane >> 5;
    const int kvh = unit & 3, blk = (unit >> 2) & 31, b = unit >> 7;
    const bf16_t* P = (const bf16_t*)(a.ws + WS_PROJ);
    bf16_t* ZT = (bf16_t*)(a.ws + WS_ZT);
    const size_t rowb = (size_t)b * SEQ;
    const int kbase = blk * 128 - 128;
    const int g = wid >> 1, head = kvh * 4 + g;
    bf16x8 qfa[2][4];
#pragma unroll
    for (int qt = 0; qt < 2; ++qt) { const size_t qrow_ = rowb + blk * 128 + 64 * (wid & 1) + 32 * qt + r;
#pragma unroll
        for (int ds = 0; ds < 4; ++ds) qfa[qt][ds] = *(const bf16x8*)(P + qrow_ * LDP + PC_Q + head * 64 + ds * 16 + 8 * hh); }
    for (int srep = 0; srep < ((PROBE_ATT & 1) ? 2 : 1); ++srep) {
    if (srep) __syncthreads();
#pragma unroll
    for (int i = 0; i < 6; ++i) { const int c = tid + 512 * i, kv = c >> 3, dch = c & 7, kabs = kbase + kv;
        u32x4 v = (u32x4){0u, 0u, 0u, 0u};
        if ((unsigned)kabs < (unsigned)SEQ) v = *(const u32x4*)(P + (rowb + kabs) * LDP + PC_K + kvh * 64 + dch * 8);
        *(LAS u32x4*)(lds + AT_K + kv * AT_KP + dch * 16) = v; }
#pragma unroll
    for (int i = 0; i < 6; ++i) { const int c = tid + 512 * i, kv = c >> 3, dch = c & 7, kabs = kbase + kv;
        u32x4 v = (u32x4){0u, 0u, 0u, 0u};
        if ((unsigned)kabs < (unsigned)SEQ) v = *(const u32x4*)(P + (rowb + kabs) * LDP + PC_V + kvh * 64 + dch * 8);
        *(LAS u32x4*)(lds + AT_V + kv * AT_KP + dch * 16) = v; }
    }
    __syncthreads();
    const float sink8 = a.attn_sink[l * NH + head] * 8.0f;
    const int tlo = blk == 0 ? 4 : 0, thi = blk == 31 ? 8 : 12;
    const LAS float* bt = (const LAS float*)(lds + AT_B) + head * AT_BP;
#pragma unroll 1
    for (int qtt = 0; qtt < ((PROBE_ATT & 2) ? 4 : 2); ++qtt) { const int qt = qtt & 1;
        const int qo = 64 * (wid & 1) + 32 * qt, qrel = qo + r, t0 = qo >> 5;
        const size_t qrow = rowb + blk * 128 + qrel;
        bf16x8 qf[4];
#pragma unroll
        for (int ds = 0; ds < 4; ++ds) qf[ds] = qt == 0 ? qfa[0][ds] : qfa[1][ds];
        bf16_t* orow = ZT + qrow * DM + head * 64;
        attn_qtile(lds, bt, qf, lane, r, hh, qrel, t0, tlo, thi, sink8, orow);
    }
    __syncthreads();
}

#define XB_TMO      128
#define XB_XCNT(j)  (256  + 64 * (j))
#define XB_XSUB(j)  (1280 + 64 * (j))
#define XB_XGEN(j)  (2304 + 64 * (j))
#define XB_TOP      3328
#define XB_TOPGEN   3392
#define XCD_BAR_WORDS 3456
#define XB_SPIN_CAP (1u << 18)
__device__ __forceinline__ unsigned xb_ld(unsigned* p)              { return __hip_atomic_load(p, __ATOMIC_RELAXED, __HIP_MEMORY_SCOPE_AGENT); }
__device__ __forceinline__ unsigned xb_add(unsigned* p, unsigned v) { return __hip_atomic_fetch_add(p, v, __ATOMIC_RELAXED, __HIP_MEMORY_SCOPE_AGENT); }
__device__ __forceinline__ unsigned xb_xcc_id() { return (unsigned)__builtin_amdgcn_s_getreg((3 << 11) | 20) & 0xFu; }
#define XB_SPIN(cond, bar) do { unsigned _sp = 0; while (cond) { __builtin_amdgcn_s_sleep(1); \
    if ((++_sp & 255u) == 0u) { if (xb_ld(&(bar)[XB_TMO])) break; if (_sp > XB_SPIN_CAP) { atomicAdd(&(bar)[XB_TMO], 1u); break; } } } } while (0)
struct XcdBarrier { unsigned* bar; unsigned x; volatile LAS unsigned* st; };
__device__ __forceinline__ XcdBarrier xcd_barrier_post(unsigned* bar, volatile LAS unsigned* st) {
    XcdBarrier b; b.bar = bar; b.x = xb_xcc_id(); b.st = st;
    if (threadIdx.x == 0) (void)xb_add(&bar[XB_XCNT(b.x)], 1u);
    return b;
}
__device__ __forceinline__ void xcd_barrier_complete(unsigned* bar, unsigned x, unsigned& nloc, unsigned& nx) {
    const unsigned G = gridDim.x * gridDim.y * gridDim.z;
    unsigned sum, cnt, mine, sp = 0u;
    for (;;) {
        sum = 0u; cnt = 0u; mine = 0u;
#pragma unroll
        for (unsigned j = 0; j < 16; ++j) { const unsigned c = xb_ld(&bar[XB_XCNT(j)]); sum += c; cnt += (c > 0u) ? 1u : 0u; mine = (j == x) ? c : mine; }
        if (sum == G) break;
        __builtin_amdgcn_s_sleep(1);
        if ((++sp & 255u) == 0u) { if (xb_ld(&bar[XB_TMO])) break; if (sp > XB_SPIN_CAP) { atomicAdd(&bar[XB_TMO], 1u); break; } }
    }
    nloc = mine > 0u ? mine : 1u; nx = cnt > 0u ? cnt : 1u;
}
__device__ __forceinline__ void xcd_barrier(const XcdBarrier& b) {
    asm volatile("s_waitcnt vmcnt(0)" ::: "memory");
    __syncthreads();
    if (threadIdx.x == 0) {
        unsigned* bar = b.bar;
        __builtin_amdgcn_s_waitcnt(0);
        unsigned nloc = b.st[0], nx = b.st[1];
        if (nloc == 0u) { xcd_barrier_complete(bar, b.x, nloc, nx); b.st[0] = nloc; b.st[1] = nx; }
        const unsigned old = xb_add(&bar[XB_XSUB(b.x)], 1u);
        const unsigned gen = old / nloc;
        if (old + 1u == (gen + 1u) * nloc) {
            __builtin_amdgcn_fence(__ATOMIC_RELEASE, "agent");
            asm volatile("s_waitcnt vmcnt(0)" ::: "memory");
            const unsigned og = xb_add(&bar[XB_TOP], 1u);
            const unsigned tg = og / nx;
            if (og + 1u == (tg + 1u) * nx) xb_add(&bar[XB_TOPGEN], 1u);
            else XB_SPIN(xb_ld(&bar[XB_TOPGEN]) == tg, bar);
            __builtin_amdgcn_fence(__ATOMIC_ACQUIRE, "agent");
            xb_add(&bar[XB_XGEN(b.x)], 1u);
            asm volatile("s_waitcnt vmcnt(0)" ::: "memory");
        } else {
            XB_SPIN(xb_ld(&bar[XB_XGEN(b.x)]) == gen, bar);
            __builtin_amdgcn_fence(__ATOMIC_ACQUIRE, "agent");
            asm volatile("s_waitcnt vmcnt(0)" ::: "memory");
        }
    }
    __syncthreads();
}

__global__ void __launch_bounds__(512, 2) fwd_megakernel(Args a) {
    extern __shared__ __attribute__((aligned(16))) unsigned char lds_raw[];
    LAS unsigned char* lds = (LAS unsigned char*)lds_raw;
    cg::grid_group grid = cg::this_grid();
    const int G = gridDim.x, bx = blockIdx.x;
#define PH_TID() int tid = threadIdx.x; asm volatile("" : "+v"(tid)); const int lane = tid & 63, wave = __builtin_amdgcn_readfirstlane(tid >> 6); (void)lane; (void)wave
    unsigned char* ws = a.ws;
    volatile LAS unsigned* bst = (volatile LAS unsigned*)(lds + 131072);
    if (threadIdx.x < 2) bst[threadIdx.x] = 0u;
    __syncthreads();
    const XcdBarrier bar = xcd_barrier_post((unsigned*)(ws + WS_CTL), bst);
    if (a.ph_lo > a.ph_hi) grid.sync();
#define GRID_BAR() xcd_barrier(bar)
    bf16_t* PROJ = (bf16_t*)(ws + WS_PROJ); bf16_t* ACT = PROJ; bf16_t* HB = (bf16_t*)(ws + WS_HB); bf16_t* XB = (bf16_t*)(ws + WS_XB); float* PART = (float*)(ws + WS_PART);
    float* X = a.out;

    for (int p = a.ph_lo; p < a.ph_hi; ++p) {
        const int l = p >> 3, sub = p & 7;
        const unsigned char* wsw = ws + ((l & 1) ? WS_WBUF1 : (size_t)0);
        if (p < 8 * DEPTH && (sub == 5 || (sub == 0 && l > 0))) continue;
        for (int rep = 0; rep < ((p < 8 * DEPTH && ((PROBE_REP_MASK >> sub) & 1)) ? 2 : 1); ++rep) {
        if (rep) GRID_BAR();
        if (p == 8 * DEPTH) {
            PH_TID();
            for (int m = bx * 8 + wave; m < M; m += G * 8) rms_row_f32(X + (size_t)m * DM, a.g_final, X + (size_t)m * DM, lane);
        } else if (sub == 0) {
            PH_TID();
#ifndef DIS_CVT
            convert_weights(a, l, (LAS float*)(lds + wave * 16384), bx * 8 + wave, G * 8, lane, 0, IT_TOTAL);
#endif
            if (l == 0) for (int m = bx * 8 + wave; m < M; m += G * 8) prep_row(a.x + (size_t)m * DM, XB + (size_t)m * DM, PART + (size_t)m * 16, lane);
        } else if (sub == 1) {
            pg8::Gemm g{XB, (const bf16_t*)(wsw + WS_WIN), M, INTOT, DM, DM, DM, 0}; pg8::StaticOrder S; S.init(M, INTOT, G, bx);
            pg8::EpiProj E{PROJ, PART};
#ifndef DIS_PROJ
            pg8::gemm_phase<pg8::EpiProj, pg8::StaticOrder>(lds, g, S, E);
#endif
            if (l + 1 < DEPTH) convert_in_tail(a, l + 1, lds, S.nwg, G, bx, 0, IT_SPLIT);
        } else if (sub == 2) {
            PH_TID();
            { LAS float* bt = (LAS float*)(lds + AT_B);
              for (int i = tid; i < 16 * AT_BP; i += 512) { const int h = i / AT_BP, idx = i - h * AT_BP - 32;
                  bt[i] = ((unsigned)idx <= 256u) ? a.rel_bias[t5_bucket(idx - 128) * NH + h] * 8.0f : -INFINITY; } }
            __syncthreads();
            if (bx & 1) {
                for (int rr = 0; rr < ((PROBE_MIX & 2) ? 2 : 1); ++rr) convpool_phase(a, l, bx * 8 + wave, G * 8, lane);
            }
#ifndef DIS_ATTN
            for (int rr = 0; rr < ((PROBE_MIX & 1) ? 2 : 1); ++rr)
            for (int u = bx; u < BATCH * 32 * NKV; u += G) attn_unit(a, l, u, lds);
#endif
            if (!(bx & 1)) {
                for (int rr = 0; rr < ((PROBE_MIX & 2) ? 2 : 1); ++rr) convpool_phase(a, l, bx * 8 + wave, G * 8, lane);
            }
        } else if (sub == 3) {
            pg8::Gemm g{(const bf16_t*)(ws + WS_ZA), (const bf16_t*)(wsw + WS_WA), M, DM, DM, DM, DM, 0,
                        (const bf16_t*)(ws + WS_ZP), (const bf16_t*)(wsw + WS_WP), 256, 1,
                        (const bf16_t*)(ws + WS_ZT), (const bf16_t*)(wsw + WS_WT), DM, 0};
            pg8::MergeOrder S; S.init(M, DM, G, bx);
            pg8::EpiMerge E{HB, PROJ + PC_G};
#ifndef DIS_MERGE
            pg8::gemm_phase<pg8::EpiMerge, pg8::MergeOrder>(lds, g, S, E);
#endif
        } else if (sub == 4 || sub == 7) {
            pg8::Gemm g; pg8::StaticOrder S; S.init(M, DM, G, bx);
            if (sub == 4) g = pg8::Gemm{HB, (const bf16_t*)(wsw + WS_WO), M, DM, DM, DM, DM, 0};
            else g = pg8::Gemm{ACT, (const bf16_t*)(wsw + WS_WD), M, DM, DFF, DFF, DFF, 0};
            pg8::EpiResid E{(sub == 4 && l == 0) ? a.x : (const float*)X, X, XB, PART};
#ifndef DIS_RESID
            pg8::gemm_phase<pg8::EpiResid, pg8::StaticOrder>(lds, g, S, E);
#endif
        } else {
            pg8::Gemm g{XB, (const bf16_t*)(wsw + WS_WGU), M, 2 * DFF, DM, DM, DM, 0}; pg8::StaticOrder S; S.init(M, 2 * DFF, G, bx);
            pg8::EpiAct E{ACT, PART};
#ifndef DIS_ACT
            pg8::gemm_phase<pg8::EpiAct, pg8::StaticOrder>(lds, g, S, E);
#endif
            if (l + 1 < DEPTH) convert_in_tail(a, l + 1, lds, S.nwg, G, bx, IT_SPLIT, IT_TOTAL);
        }
        }
        if (p + 1 < a.ph_hi) { GRID_BAR(); for (int xs = 0; xs < PROBE_XSYNC; ++xs) GRID_BAR(); }
    }
}

extern "C" void kernel_launch(void* const* d_in, const int* in_sizes, int n_in, void* d_out, int out_size, void* d_ws, size_t ws_size, hipStream_t stream) {
    static int grid = 0;
    if (grid == 0) {
        if (n_in != 15 || out_size != M * DM || ws_size < WS_END) { fprintf(stderr, "kernel_launch: unexpected problem (n_in %d out %d ws %zu)\n", n_in, out_size, ws_size); grid = -1; return; }
        int dev = 0, cus = 0, per_cu = 0;
        hipGetDevice(&dev); hipDeviceGetAttribute(&cus, hipDeviceAttributeMultiprocessorCount, dev);
        hipFuncSetAttribute((const void*)fwd_megakernel, hipFuncAttributeMaxDynamicSharedMemorySize, LDS_BYTES);
        hipOccupancyMaxActiveBlocksPerMultiprocessor(&per_cu, (const void*)fwd_megakernel, 512, LDS_BYTES);
        (void)hipGetLastError();
        if (per_cu < 1) { fprintf(stderr, "kernel_launch: occupancy query says %d blocks/CU\n", per_cu); per_cu = 1; }
        grid = cus;
    }
    if (grid < 0) return;
    Args a{};
    a.x = (const float*)d_in[0]; a.w_in = (const float*)d_in[1]; a.conv_w = (const float*)d_in[2]; a.w_a_out = (const float*)d_in[3];
    a.w_pool = (const float*)d_in[4]; a.pool_scale = (const float*)d_in[5]; a.w_attn_out = (const float*)d_in[6]; a.attn_sink = (const float*)d_in[7];
    a.w_o = (const float*)d_in[8]; a.g_mix = (const float*)d_in[9]; a.g_ffn = (const float*)d_in[10]; a.w_gu = (const float*)d_in[11];
    a.w_down = (const float*)d_in[12]; a.rel_bias = (const float*)d_in[13]; a.g_final = (const float*)d_in[14];
    a.out = (float*)d_out; a.ws = (unsigned char*)d_ws;
    hipMemsetAsync((unsigned char*)d_ws + WS_CTL, 0, CTL_BYTES, stream);
#if MK_MULTI
    for (int p = 0; p <= 8 * DEPTH; ++p) { a.ph_lo = p; a.ph_hi = p + 1; hipLaunchKernelGGL(fwd_megakernel, dim3(grid), dim3(512), LDS_BYTES, stream, a); }
#else
    a.ph_lo = 0; a.ph_hi = 8 * DEPTH + 1;
    void* args[] = {&a};
    hipError_t e = hipLaunchCooperativeKernel((const void*)fwd_megakernel, dim3(grid), dim3(512), args, LDS_BYTES, stream);
    if (e != hipSuccess) fprintf(stderr, "cooperative launch failed: %s (grid %d)\n", hipGetErrorString(e), grid);
#endif
}
```
